# Optimizing an MI355X kernel written in HIP

```python
import math
import jax
import jax.numpy as jnp
from jax import lax
import numpy as np

D_MODEL = 1024
BATCH = 1
SEQ = 16384
DEPTH = 4

GRID_W = 64
CTX_LEN = 256
HEAD_DIM = 64
A_HEADS = 4
A_VDIM = 2 * HEAD_DIM
B_HEADS = 8
B_KV_HEADS = 2
C_HEADS = D_MODEL // HEAD_DIM
NA_WIN_H = 8
NA_WIN_W = 16
RPB_H = 2 * NA_WIN_H - 1
RPB_W = 2 * NA_WIN_W - 1
N_GROUPS = 4
EXPERTS_PER_GROUP = 8
N_EXPERTS = N_GROUPS * EXPERTS_PER_GROUP
TOP_K_INNER = 2
D_EXPERT = 512
MOE_BLOCK = 128
Q_BLOCK = 128
ROPE_THETA = 10000.0
N_EVEN = (DEPTH + 1) // 2
N_ODD = DEPTH // 2
DN_ALPHA = (2.0 * DEPTH) ** 0.25
DN_BETA = (8.0 * DEPTH) ** -0.25
A_QK = A_HEADS * 2 * HEAD_DIM
A_V = A_HEADS * A_VDIM
B_Q = B_HEADS * HEAD_DIM
B_KV = B_KV_HEADS * HEAD_DIM
EVEN_IN = 2 * A_QK + A_V + B_Q + 2 * B_KV
EVEN_OUT = A_V + B_Q
C_WIDTH = C_HEADS * HEAD_DIM
ODD_IN = 3 * C_WIDTH

kernel_name = "hybrid_diffattn_gqa_natten_hmoe_deepnorm"


def layer_norm(x, g, b, eps=1e-6):
    xf = x.astype(jnp.float32)
    mu = jnp.mean(xf, axis=-1, keepdims=True)
    var = jnp.mean(jnp.square(xf - mu), axis=-1, keepdims=True)
    return ((xf - mu) * lax.rsqrt(var + eps) * g.astype(jnp.float32) + b.astype(jnp.float32)).astype(x.dtype)


def rms_norm(x, g, eps=1e-6):
    xf = x.astype(jnp.float32)
    ms = jnp.mean(jnp.square(xf), axis=-1, keepdims=True)
    return (xf * lax.rsqrt(ms + eps) * g.astype(jnp.float32)).astype(x.dtype)


def softmax_f32(s):
    return jax.nn.softmax(s.astype(jnp.float32), axis=-1)


def axial_rope_tables(n_tokens):
    t = jnp.arange(n_tokens, dtype=jnp.int32)
    row = (t // GRID_W).astype(jnp.float32)
    col = (t % GRID_W).astype(jnp.float32)
    half = HEAD_DIM // 2
    inv = ROPE_THETA ** (-jnp.arange(0, half, 2, dtype=jnp.float32) / half)
    ang_r = row[:, None] * inv[None, :]
    ang_c = col[:, None] * inv[None, :]
    ang = jnp.concatenate([ang_r, ang_r, ang_c, ang_c], axis=-1)
    return jnp.cos(ang), jnp.sin(ang)


def rotate_axial(x):
    q = HEAD_DIM // 4
    x1, x2, x3, x4 = x[..., :q], x[..., q:2 * q], x[..., 2 * q:3 * q], x[..., 3 * q:]
    return jnp.concatenate([-x2, x1, -x4, x3], axis=-1)


def apply_rope(x, cos, sin):
    shape = (1, x.shape[1]) + (1,) * (x.ndim - 3) + (HEAD_DIM,)
    xf = x.astype(jnp.float32)
    return (xf * cos.reshape(shape) + rotate_axial(xf) * sin.reshape(shape)).astype(x.dtype)


def neighbourhood_tables(n_tokens):
    rows = n_tokens // GRID_W
    kh = min(NA_WIN_H, rows)
    kw = NA_WIN_W
    t = jnp.arange(n_tokens, dtype=jnp.int32)
    r = t // GRID_W
    c = t % GRID_W
    rs = jnp.clip(r - kh // 2, 0, rows - kh)
    cs = jnp.clip(c - kw // 2, 0, GRID_W - kw)
    kr = rs[:, None, None] + jnp.arange(kh, dtype=jnp.int32)[None, :, None]
    kc = cs[:, None, None] + jnp.arange(kw, dtype=jnp.int32)[None, None, :]
    idx = (kr * GRID_W + kc).reshape(n_tokens, kh * kw)
    bidx = ((kr - r[:, None, None] + (NA_WIN_H - 1)) * RPB_W
            + (kc - c[:, None, None] + (NA_WIN_W - 1))).reshape(n_tokens, kh * kw)
    return idx, bidx


def to_blocks(a):
    b, n = a.shape[:2]
    return jnp.swapaxes(a.reshape((b, n // Q_BLOCK, Q_BLOCK) + a.shape[2:]), 0, 1)


def from_blocks(o):
    nb, b, q = o.shape[:3]
    return jnp.swapaxes(o, 0, 1).reshape((b, nb * q) + o.shape[3:])


def diff_attn_core(q, k, v, lam, lam_init, sub_g):
    b, nq = q.shape[:2]
    s = jnp.einsum('bqhmd,bkhmd->bhmqk', q, k) * (HEAD_DIM ** -0.5)
    p = softmax_f32(s)
    a = (p[:, :, 0] - lam * p[:, :, 1]).astype(v.dtype)
    o = jnp.einsum('bhqk,bkhe->bqhe', a, v)
    o = rms_norm(o, sub_g) * (1.0 - lam_init)
    return o.reshape(b, nq, A_V)


def gqa_core(q, k, v):
    b, nq = q.shape[:2]
    q = q.reshape(b, nq, B_KV_HEADS, B_HEADS // B_KV_HEADS, HEAD_DIM)
    s = jnp.einsum('bqgrd,bkgd->bgrqk', q, k) * (HEAD_DIM ** -0.5)
    p = softmax_f32(s).astype(v.dtype)
    o = jnp.einsum('bgrqk,bkgd->bqgrd', p, v)
    return o.reshape(b, nq, B_Q)


def even_mixer(h_lat, h_ctx, w_in, w_out, lam_vec, sub_g, qk_g, lam_init, cos, sin, with_ctx):
    b = h_lat.shape[0]
    splits = [A_QK, 2 * A_QK, 2 * A_QK + A_V, 2 * A_QK + A_V + B_Q, 2 * A_QK + A_V + B_Q + B_KV]

    def project(h):
        s = h.shape[1]
        aq, ak, av, bq, bk, bv = jnp.split(h @ w_in, splits, axis=-1)
        aq = aq.reshape(b, s, A_HEADS, 2, HEAD_DIM)
        ak = ak.reshape(b, s, A_HEADS, 2, HEAD_DIM)
        av = av.reshape(b, s, A_HEADS, A_VDIM)
        bq = rms_norm(bq.reshape(b, s, B_HEADS, HEAD_DIM), qk_g[0])
        bk = rms_norm(bk.reshape(b, s, B_KV_HEADS, HEAD_DIM), qk_g[1])
        bv = bv.reshape(b, s, B_KV_HEADS, HEAD_DIM)
        return aq, ak, av, bq, bk, bv

    aq_l, ak_l, av_l, bq_l, bk_l, bv_l = project(h_lat)
    aq_l = apply_rope(aq_l, cos, sin)
    ak_l = apply_rope(ak_l, cos, sin)
    bq_l = apply_rope(bq_l, cos, sin)
    bk_l = apply_rope(bk_l, cos, sin)
    aq_c, ak_c, av_c, bq_c, bk_c, bv_c = project(h_ctx)
    lamf = lam_vec.astype(jnp.float32)
    lam = jnp.exp(jnp.sum(lamf[0] * lamf[1])) - jnp.exp(jnp.sum(lamf[2] * lamf[3])) + lam_init
    ak_all = jnp.concatenate([ak_c, ak_l], axis=1)
    av_all = jnp.concatenate([av_c, av_l], axis=1)
    bk_all = jnp.concatenate([bk_c, bk_l], axis=1)
    bv_all = jnp.concatenate([bv_c, bv_l], axis=1)

    def block(args):
        aq_b, bq_b = args
        return jnp.concatenate([diff_attn_core(aq_b, ak_all, av_all, lam, lam_init, sub_g),
                                gqa_core(bq_b, bk_all, bv_all)], axis=-1)

    out_l = from_blocks(lax.map(block, (to_blocks(aq_l), to_blocks(bq_l)))) @ w_out
    if not with_ctx:
        return out_l, None
    out_c = jnp.concatenate([diff_attn_core(aq_c, ak_c, av_c, lam, lam_init, sub_g),
                             gqa_core(bq_c, bk_c, bv_c)], axis=-1) @ w_out
    return out_l, out_c


def odd_mixer(h_lat, h_ctx, w_in, w_out, rpb, nbr_idx, bias_idx, with_ctx):
    b = h_lat.shape[0]

    def project(h):
        s = h.shape[1]
        q, k, v = jnp.split(h @ w_in, 3, axis=-1)
        return (q.reshape(b, s, C_HEADS, HEAD_DIM), k.reshape(b, s, C_HEADS, HEAD_DIM),
                v.reshape(b, s, C_HEADS, HEAD_DIM))

    q_l, k_l, v_l = project(h_lat)
    q_c, k_c, v_c = project(h_ctx)
    rpb_flat = rpb.reshape(C_HEADS, RPB_H * RPB_W)
    scale = HEAD_DIM ** -0.5
    n_nbr = nbr_idx.shape[1]

    def block(args):
        q_b, idx_b, bidx_b = args
        k_nb = k_l[:, idx_b]
        v_nb = v_l[:, idx_b]
        s_nb = jnp.einsum('bqhd,bqnhd->bhqn', q_b, k_nb) * scale + rpb_flat[:, bidx_b][None]
        s_cx = jnp.einsum('bqhd,bkhd->bhqk', q_b, k_c) * scale
        p = softmax_f32(jnp.concatenate([s_nb, s_cx], axis=-1)).astype(v_l.dtype)
        o = (jnp.einsum('bhqn,bqnhd->bqhd', p[..., :n_nbr], v_nb)
             + jnp.einsum('bhqk,bkhd->bqhd', p[..., n_nbr:], v_c))
        return o.reshape(b, q_b.shape[1], C_WIDTH)

    nb = nbr_idx.shape[0] // Q_BLOCK
    out_l = from_blocks(lax.map(block, (to_blocks(q_l),
                                        nbr_idx.reshape(nb, Q_BLOCK, n_nbr),
                                        bias_idx.reshape(nb, Q_BLOCK, n_nbr)))) @ w_out
    if not with_ctx:
        return out_l, None
    s = jnp.einsum('bqhd,bkhd->bhqk', q_c, k_c) * scale
    p = softmax_f32(s).astype(v_c.dtype)
    out_c = jnp.einsum('bhqk,bkhd->bqhd', p, v_c).reshape(b, q_c.shape[1], C_WIDTH) @ w_out
    return out_l, out_c


def hier_moe(h, router_g, router_e, w1, w3, w2):
    n_tok = h.shape[0]
    lg = (h @ router_g).astype(jnp.float32)
    pg = jax.nn.softmax(lg, axis=-1)
    g_star = jnp.argmax(lg, axis=-1).astype(jnp.int32)
    p_top = jnp.take_along_axis(pg, g_star[:, None], axis=1)
    le = (h @ router_e).astype(jnp.float32).reshape(n_tok, N_GROUPS, EXPERTS_PER_GROUP)
    le_g = jnp.take_along_axis(le, g_star[:, None, None], axis=1)[:, 0]
    top_v, top_i = lax.top_k(le_g, TOP_K_INNER)
    gate = jax.nn.softmax(top_v, axis=-1) * p_top
    expert = g_star[:, None] * EXPERTS_PER_GROUP + top_i.astype(jnp.int32)
    n_assign = n_tok * TOP_K_INNER
    e_flat = expert.reshape(-1)
    tok_flat = jnp.repeat(jnp.arange(n_tok, dtype=jnp.int32), TOP_K_INNER)
    w_flat = gate.reshape(-1)
    order = jnp.argsort(e_flat)
    e_s, tok_s, w_s = e_flat[order], tok_flat[order], w_flat[order]
    counts = jnp.zeros((N_EXPERTS,), jnp.int32).at[e_flat].add(1)
    starts = jnp.cumsum(counts) - counts
    padded = (counts + MOE_BLOCK - 1) // MOE_BLOCK * MOE_BLOCK
    pad_ends = jnp.cumsum(padded)
    pad_starts = pad_ends - padded
    dest = pad_starts[e_s] + jnp.arange(n_assign, dtype=jnp.int32) - starts[e_s]
    n_blocks = (n_assign + MOE_BLOCK - 1) // MOE_BLOCK + N_EXPERTS
    n_rows = n_blocks * MOE_BLOCK
    row_tok = jnp.zeros((n_rows,), jnp.int32).at[dest].set(tok_s)
    row_w = jnp.zeros((n_rows,), jnp.float32).at[dest].set(w_s)
    block_exp = jnp.minimum(jnp.searchsorted(pad_ends, jnp.arange(n_blocks, dtype=jnp.int32) * MOE_BLOCK,
                                             side='right'), N_EXPERTS - 1).astype(jnp.int32)

    def expert_block(args):
        tok_b, e = args
        xb = h[tok_b]
        return (jax.nn.silu(xb @ w1[e]) * (xb @ w3[e])) @ w2[e]

    y = lax.map(expert_block, (row_tok.reshape(n_blocks, MOE_BLOCK), block_exp))
    y = y.reshape(n_rows, h.shape[1]) * row_w[:, None].astype(h.dtype)
    return jnp.zeros_like(h).at[row_tok].add(y)


def setup_inputs(seed: int = 0) -> dict:
    key = jax.random.key(seed)
    ks = jax.random.split(key, 21)
    D = D_MODEL

    def nrm(k, shape, scale):
        return jax.random.normal(k, shape, jnp.float32) * scale

    return {
        "x": nrm(ks[0], (BATCH, SEQ, D), 1.0),
        "c": nrm(ks[1], (BATCH, D), 1.0),
        "ctx": nrm(ks[2], (BATCH, CTX_LEN, D), 1.0),
        "c_ctx": nrm(ks[3], (D,), 1.0),
        "w_mod": nrm(ks[4], (DEPTH, D, 6 * D), 0.5 * D ** -0.5),
        "b_mod": nrm(ks[5], (DEPTH, 6 * D), 0.01),
        "ln_g": 1.0 + nrm(ks[6], (DEPTH, 2, D), 0.02),
        "ln_b": nrm(ks[7], (DEPTH, 2, D), 0.01),
        "w_in_even": nrm(ks[8], (N_EVEN, D, EVEN_IN), D ** -0.5),
        "w_out_even": nrm(ks[9], (N_EVEN, EVEN_OUT, D), DN_BETA * EVEN_OUT ** -0.5),
        "diff_lam": nrm(ks[10], (N_EVEN, 4, HEAD_DIM), 0.1),
        "diff_subln_g": 1.0 + nrm(ks[11], (N_EVEN, A_VDIM), 0.02),
        "gqa_qk_g": 1.0 + nrm(ks[12], (N_EVEN, 2, HEAD_DIM), 0.02),
        "w_in_odd": nrm(ks[13], (N_ODD, D, ODD_IN), D ** -0.5),
        "w_out_odd": nrm(ks[14], (N_ODD, C_WIDTH, D), DN_BETA * C_WIDTH ** -0.5),
        "na_rpb": nrm(ks[15], (N_ODD, C_HEADS, RPB_H, RPB_W), 0.02),
        "router_g": nrm(ks[16], (DEPTH, D, N_GROUPS), D ** -0.5),
        "router_e": nrm(ks[17], (DEPTH, D, N_EXPERTS), D ** -0.5),
        "w1": nrm(ks[18], (DEPTH, N_EXPERTS, D, D_EXPERT), D ** -0.5),
        "w3": nrm(ks[19], (DEPTH, N_EXPERTS, D, D_EXPERT), D ** -0.5),
        "w2": nrm(ks[20], (DEPTH, N_EXPERTS, D_EXPERT, D), DN_BETA * D_EXPERT ** -0.5),
    }


def reference(x, c, ctx, c_ctx, w_mod, b_mod, ln_g, ln_b, w_in_even, w_out_even, diff_lam, diff_subln_g,
              gqa_qk_g, w_in_odd, w_out_odd, na_rpb, router_g, router_e, w1, w3, w2):
    b, n, d = x.shape
    n_ctx = ctx.shape[1]
    cos, sin = axial_rope_tables(n)
    nbr_idx, bias_idx = neighbourhood_tables(n)
    s_c = jax.nn.silu(c)
    s_cc = jax.nn.silu(c_ctx)
    for l in range(DEPTH):
        last = l == DEPTH - 1
        i = l // 2
        mod = (s_c @ w_mod[l] + b_mod[l])[:, None, :]
        mod_c = s_cc @ w_mod[l] + b_mod[l]
        sh1, sc1, g1, sh2, sc2, g2 = jnp.split(mod, 6, axis=-1)
        csh1, csc1, cg1, csh2, csc2, cg2 = jnp.split(mod_c, 6, axis=-1)
        h_l = x * (1.0 + sc1) + sh1
        h_c = ctx * (1.0 + csc1) + csh1
        if l % 2 == 0:
            lam_init = 0.8 - 0.6 * math.exp(-0.3 * l)
            mix_l, mix_c = even_mixer(h_l, h_c, w_in_even[i], w_out_even[i], diff_lam[i], diff_subln_g[i],
                                      gqa_qk_g[i], lam_init, cos, sin, not last)
        else:
            mix_l, mix_c = odd_mixer(h_l, h_c, w_in_odd[i], w_out_odd[i], na_rpb[i], nbr_idx, bias_idx, not last)
        x = layer_norm(DN_ALPHA * x + g1 * mix_l, ln_g[l, 0], ln_b[l, 0])
        if not last:
            ctx = layer_norm(DN_ALPHA * ctx + cg1 * mix_c, ln_g[l, 0], ln_b[l, 0])
        h2_l = (x * (1.0 + sc2) + sh2).reshape(b * n, d)
        if last:
            y_l = hier_moe(h2_l, router_g[l], router_e[l], w1[l], w3[l], w2[l]).reshape(b, n, d)
        else:
            h2_c = (ctx * (1.0 + csc2) + csh2).reshape(b * n_ctx, d)
            y = hier_moe(jnp.concatenate([h2_c, h2_l], axis=0), router_g[l], router_e[l], w1[l], w3[l], w2[l])
            y_l = y[b * n_ctx:].reshape(b, n, d)
            ctx = layer_norm(DN_ALPHA * ctx + cg2 * y[:b * n_ctx].reshape(b, n_ctx, d), ln_g[l, 1], ln_b[l, 1])
        x = layer_norm(DN_ALPHA * x + g2 * y_l, ln_g[l, 1], ln_b[l, 1])
    return x
```

```cpp
#include <hip/hip_runtime.h>
#include <hip/hip_bf16.h>
#include <cstdio>
#include <cstdint>

#ifndef MK_ONE_LAUNCH
#define MK_ONE_LAUNCH 1
#endif

constexpr int D = 1024, SEQ = 16384, NCTX = 256, M = SEQ + NCTX, DEPTH = 4;
constexpr int EVEN_IN = 2304, ODD_IN = 3072;
constexpr int NE = 32, DE = 512;
constexpr int AS_TILES = 162, AS_ROWS = AS_TILES * 256;
constexpr float DN_ALPHA = 1.6817928305074290f;
constexpr float LOG2E = 1.4426950408889634f;
constexpr float C2 = 0.125f * LOG2E;
constexpr float LN_EPS = 1e-6f;

namespace pg8 {
#define PG8_LAS __attribute__((address_space(3)))
typedef unsigned short bf16_t;
typedef short bf16x8 __attribute__((ext_vector_type(8)));
typedef float f32x4 __attribute__((ext_vector_type(4)));
typedef unsigned u32x4 __attribute__((ext_vector_type(4)));
constexpr int BM = 256, BK = 64, HALF = 128, HTB = HALF * BK * 2, STAGE_BYTES = 8 * HTB, NXCD = 8, WGM = 8;

__host__ __device__ __forceinline__ int lds_byte(int r, int c) { const int st = (r >> 4) * 2 + (c >> 5), rr = r & 15, cc = c & 31, ob = rr * 64 + cc * 2; return st * 1024 + (ob ^ (((ob >> 9) & 1) << 5)); }
__host__ __device__ __forceinline__ void stage_rc(int b, int& R, int& C) { const int st = b / 1024, sb = b % 1024, swz = sb ^ (((sb >> 9) & 1) << 5); R = (st >> 1) * 16 + swz / 64; C = (st & 1) * 32 + (swz % 64) / 2; }
__host__ __device__ __forceinline__ int perm32(int rho) { const int n = rho >> 4, i = rho & 15; return 8 * (i >> 2) + 4 * n + (i & 3); }

struct Unit { int pm, pn, hs; };
struct Gemm { const bf16_t* A; const bf16_t* Bt; int M, N, K; };

struct StaticOrder {
    int nM, nN, nwg, G, c;
    __host__ __device__ void init(int M_, int N_, int G_, int c_) { nM = M_ / BM; nN = N_ / BM; nwg = nM * nN; G = G_; c = c_; }
    __host__ __device__ bool next(int i, Unit& u) const {
        const int R = nwg / G, left = nwg - R * G; long L = (long)i * G + c; u.hs = 0;
        if (left > 0 && 2 * left <= G && i == R) { if (c >= 2 * left) return false; L = (long)R * G + (c >> 1); u.hs = 1 + (c & 1); }
        if (L >= nwg) return false;
        int wgid = (int)L; { const int q = nwg / NXCD, r = nwg % NXCD, xcd = wgid % NXCD, off = wgid / NXCD; wgid = (xcd < r ? xcd * (q + 1) : r * (q + 1) + (xcd - r) * q) + off; }
        const int nig = WGM * nN, gid = wgid / nig, fm = gid * WGM, gsz = (nM - fm) < WGM ? (nM - fm) : WGM;
        u.pm = fm + ((wgid % nig) % gsz); u.pn = (wgid % nig) / gsz; return true;
    }
    __device__ __forceinline__ void a_ready(const Unit&) const {}
    __device__ __forceinline__ void done(const Unit&) const {}
};
struct PreOrder {
    int n; unsigned lo, hi;
    __device__ __forceinline__ void init(const StaticOrder& S) { Unit u; int nn = 0; unsigned l = 0u, h = 0u;
        if (S.next(0, u)) { l = (unsigned)u.pm | ((unsigned)u.pn << 8) | ((unsigned)u.hs << 12); nn = 1;
            if (S.next(1, u)) { l |= ((unsigned)u.pm | ((unsigned)u.pn << 8) | ((unsigned)u.hs << 12)) << 16; nn = 2;
                if (S.next(2, u)) { h = (unsigned)u.pm | ((unsigned)u.pn << 8) | ((unsigned)u.hs << 12); nn = 3;
                    if (S.next(3, u)) { h |= ((unsigned)u.pm | ((unsigned)u.pn << 8) | ((unsigned)u.hs << 12)) << 16; nn = 4; } } } }
        n = __builtin_amdgcn_readfirstlane(nn); lo = (unsigned)__builtin_amdgcn_readfirstlane((int)l); hi = (unsigned)__builtin_amdgcn_readfirstlane((int)h); }
    __device__ __forceinline__ unsigned aoff(const Unit&, int, int, int) const { return 0u; }
    __device__ __forceinline__ bool next(int i, Unit& u) const { if (i >= n) return false; const unsigned w = ((i & 2) ? hi : lo) >> ((i & 1) * 16); u.pm = (int)(w & 0xffu); u.pn = (int)((w >> 8) & 0xfu); u.hs = (int)((w >> 12) & 3u); return true; }
    __device__ __forceinline__ void a_ready(const Unit&) const {}
    __device__ __forceinline__ void done(const Unit&) const {}
};
constexpr int MOE_CAP = 16640;
struct MoeOrder {
    const PG8_LAS int* offs; const PG8_LAS int* cnts; const PG8_LAS int* tile_exp; int n_tiles, G, c;
    const int* elist; int lda;
    __device__ bool next(int i, Unit& u) const {
        const int nwg = n_tiles * 4; const int R = nwg / G, left = nwg - R * G; long L = (long)i * G + c; u.hs = 0;
        if (left > 0 && 2 * left <= G && i == R) { if (c >= 2 * left) return false; L = (long)R * G + (c >> 1); u.hs = 1 + (c & 1); }
        if (L >= nwg) return false;
        int wgid = (int)L; { const int q = nwg / NXCD, r = nwg % NXCD, xcd = wgid % NXCD, off = wgid / NXCD; wgid = (xcd < r ? xcd * (q + 1) : r * (q + 1) + (xcd - r) * q) + off; }
        const int mt = wgid >> 2; const int e = __builtin_amdgcn_readfirstlane(tile_exp[mt]);
        u.pm = mt; u.pn = e * 4 + (wgid & 3); return true;
    }
    __device__ __forceinline__ int aent(const Unit& u, int h, int R) const { const int e = u.pn >> 2, pos = u.pm * BM + (u.hs ? u.hs - 1 : h) * HALF + R - offs[e]; return elist[(size_t)e * MOE_CAP + pos]; }
    __device__ __forceinline__ unsigned afin(const Unit& u, int h, int R, int C, int ent) const {
        const int e = u.pn >> 2, pos = u.pm * BM + (u.hs ? u.hs - 1 : h) * HALF + R - offs[e];
        const int tok = (pos < cnts[e]) ? (ent >> 1) : 0;
        return (unsigned)(tok * lda + C) * 2u;
    }
    __device__ __forceinline__ unsigned aoff(const Unit& u, int h, int R, int C) const { return afin(u, h, R, C, aent(u, h, R)); }
    __device__ __forceinline__ void a_ready(const Unit&) const {}
    __device__ __forceinline__ void done(const Unit&) const {}
};

__device__ __forceinline__ unsigned cvt_pk_bf16(float lo, float hi) { unsigned r; asm volatile("v_cvt_pk_bf16_f32 %0, %1, %2" : "=v"(r) : "v"(lo), "v"(hi)); return r; }

struct EpiBf16S {
    static constexpr bool PERM = true, AFTER_DRAIN = false;
    bf16_t* O; int ldc; int scale_cols; float scale0;
    __device__ __forceinline__ void operator()(const f32x4 (&acc)[2][2][4][2], const Unit& u, int wr, int wc, int fr, int fq) const {
        const int row0 = u.pm * BM + (u.hs == 2 ? HALF : 0) + wr * 64 + fr; const int colt = u.pn * BM;
        const float sc = (colt < scale_cols) ? scale0 : 1.f;
        const int col0 = colt + wc * 32 + 8 * fq;
#pragma unroll
        for (int ai = 0; ai < 2; ++ai) if (ai == 0 || !u.hs)
#pragma unroll
            for (int m = 0; m < 4; ++m) { bf16_t* rowp = O + (size_t)(row0 + ai * HALF + m * 16) * ldc + col0;
#pragma unroll
                for (int bj = 0; bj < 2; ++bj) { f32x4 v0 = acc[ai][bj][m][0] * sc, v1 = acc[ai][bj][m][1] * sc;
                    u32x4 w; w.x = cvt_pk_bf16(v0[0], v0[1]); w.y = cvt_pk_bf16(v0[2], v0[3]); w.z = cvt_pk_bf16(v1[0], v1[1]); w.w = cvt_pk_bf16(v1[2], v1[3]);
                    *(u32x4*)(rowp + bj * HALF) = w; } }
    }
};
__device__ __forceinline__ float silu_f(float a) { return a * __builtin_amdgcn_rcpf(1.f + __builtin_amdgcn_exp2f(-a * 1.4426950408889634f)); }
struct EpiSwiglu {
    static constexpr bool PERM = true, AFTER_DRAIN = false;
    bf16_t* H;
    __device__ __forceinline__ void operator()(const f32x4 (&acc)[2][2][4][2], const Unit& u, int wr, int wc, int fr, int fq) const {
        const int row0 = u.pm * BM + (u.hs == 2 ? HALF : 0) + wr * 64 + fr; const int col0 = (u.pn & 3) * 128 + wc * 32 + 8 * fq;
#pragma unroll
        for (int ai = 0; ai < 2; ++ai) if (ai == 0 || !u.hs)
#pragma unroll
            for (int m = 0; m < 4; ++m) { bf16_t* rowp = H + (size_t)(row0 + ai * HALF + m * 16) * DE + col0;
                const f32x4 a0 = acc[ai][0][m][0], a1 = acc[ai][0][m][1], b0 = acc[ai][1][m][0], b1 = acc[ai][1][m][1];
                float h[8];
#pragma unroll
                for (int i = 0; i < 4; ++i) { h[i] = silu_f(a0[i]) * b0[i]; h[4 + i] = silu_f(a1[i]) * b1[i]; }
                u32x4 w; w.x = cvt_pk_bf16(h[0], h[1]); w.y = cvt_pk_bf16(h[2], h[3]); w.z = cvt_pk_bf16(h[4], h[5]); w.w = cvt_pk_bf16(h[6], h[7]);
                *(u32x4*)rowp = w; }
    }
};
struct EpiMoeOut {
    static constexpr bool PERM = true, AFTER_DRAIN = false;
    const PG8_LAS int* offs; const PG8_LAS int* cnts; const int* elist; const float* ewt; bf16_t* Y;
    __device__ __forceinline__ void operator()(const f32x4 (&acc)[2][2][4][2], const Unit& u, int wr, int wc, int fr, int fq) const {
        const int col0 = (u.pn & 3) * BM + wc * 32 + 8 * fq; const int e = u.pn >> 2; const int o0 = offs[e], cn = cnts[e];
        int tsv[2][4]; float wv[2][4];
#pragma unroll
        for (int ai = 0; ai < 2; ++ai)
#pragma unroll
            for (int m = 0; m < 4; ++m) { const int pos = u.pm * BM + (u.hs == 2 ? HALF : 0) + ai * HALF + wr * 64 + m * 16 + fr - o0; const int pc = pos < MOE_CAP ? pos : 0;
                tsv[ai][m] = elist[(size_t)e * MOE_CAP + pc]; wv[ai][m] = ewt[(size_t)e * MOE_CAP + pc]; }
#pragma unroll
        for (int ai = 0; ai < 2; ++ai) if (ai == 0 || !u.hs)
#pragma unroll
            for (int m = 0; m < 4; ++m) { const int pos = u.pm * BM + (u.hs == 2 ? HALF : 0) + ai * HALF + wr * 64 + m * 16 + fr - o0;
                if (pos < cn) { const int ts = tsv[ai][m]; const float w = wv[ai][m]; bf16_t* rowp = Y + ((size_t)(ts & 1) * M + (size_t)(ts >> 1)) * D + col0;
#pragma unroll
                    for (int bj = 0; bj < 2; ++bj) { f32x4 v0 = acc[ai][bj][m][0] * w, v1 = acc[ai][bj][m][1] * w;
                        u32x4 o; o.x = cvt_pk_bf16(v0[0], v0[1]); o.y = cvt_pk_bf16(v0[2], v0[3]); o.z = cvt_pk_bf16(v1[0], v1[1]); o.w = cvt_pk_bf16(v1[2], v1[3]);
                        *(u32x4*)(rowp + bj * HALF) = o; } } }
    }
};

template <class Epi, class Sched, int KK, bool ALIGN_EPI = false, bool GATHER = false>
__device__ __forceinline__ void gemm_phase(PG8_LAS unsigned char* lds, const Gemm g, const Sched& S, const Epi& E, const int tid) {
    const int wid = __builtin_amdgcn_readfirstlane(tid >> 6), lane = tid & 63, wr = wid >> 2, wc = wid & 3, fr = lane & 15, fq = lane >> 4;
    constexpr int K = KK, nt = K / BK;
    unsigned voffA[2], voffB[2]; int gR[2], gC[2];
#pragma unroll
    for (int i = 0; i < 2; ++i) { int R, C; stage_rc(tid * 16 + i * 8192, R, C); const int Rb = Epi::PERM ? ((R & ~31) + perm32(R & 31)) : R; gR[i] = R; gC[i] = C;
        voffA[i] = (unsigned)(R * K + C) * 2u; voffB[i] = (unsigned)(Rb * K + C) * 2u; }
    unsigned gcur[2][2] = {{0u, 0u}, {0u, 0u}}, gnxt[2][2] = {{0u, 0u}, {0u, 0u}};
    const size_t kstep = (size_t)(BK * 2);
    const size_t hstep = (size_t)HALF * K * 2;
    const size_t tstep = 2 * hstep;
    const unsigned ldsw = (unsigned)wid * 1024u;
    const int aoff = lds_byte(wr * 64 + fr, fq * 8), boff = lds_byte(wc * 32 + fr, fq * 8);
#define PG8_SA(b, h) (((b) * 2 + (h)) * HTB)
#define PG8_SB(b, h) ((4 + (b) * 2 + (h)) * HTB)
#define PG8_STAGE(bufoff, gbase, voff) do { _Pragma("unroll") for (int _i = 0; _i < 2; ++_i) \
        __builtin_amdgcn_global_load_lds((const unsigned*)((const char*)(gbase) + (voff)[_i]), (PG8_LAS unsigned*)(lds + (bufoff) + ldsw + _i * 8192), 16, 0, 0); } while (0)
#define PG8_STAGE_A(bufoff, gbase, h, goffs, hm) do { if constexpr (GATHER) { PG8_STAGE(bufoff, gbase, (goffs)[h]); } else { PG8_STAGE(bufoff, (gbase) + (h) * (hm), voffA); } } while (0)
#define PG8_GOFF(dst, u) do { int ent_[2][2]; _Pragma("unroll") for (int _h = 0; _h < 2; ++_h) _Pragma("unroll") for (int _i = 0; _i < 2; ++_i) ent_[_h][_i] = S.aent(u, _h, gR[_i]); \
        _Pragma("unroll") for (int _h = 0; _h < 2; ++_h) _Pragma("unroll") for (int _i = 0; _i < 2; ++_i) dst[_h][_i] = S.afin(u, _h, gR[_i], gC[_i], ent_[_h][_i]); } while (0)
#define PG8_LDA(dst, b, h) do { _Pragma("unroll") for (int m = 0; m < 4; ++m) _Pragma("unroll") for (int k = 0; k < 2; ++k) dst[m][k] = *(const PG8_LAS bf16x8*)(lds + PG8_SA(b, h) + aoff + m * 2048 + k * 1024); } while (0)
#define PG8_LDB(dst, b, h) do { _Pragma("unroll") for (int n = 0; n < 2; ++n) _Pragma("unroll") for (int k = 0; k < 2; ++k) dst[n][k] = *(const PG8_LAS bf16x8*)(lds + PG8_SB(b, h) + boff + n * 2048 + k * 1024); } while (0)
#define PG8_MMA(ai, bj, At, Bt) do { __builtin_amdgcn_s_setprio(1); _Pragma("unroll") for (int m = 0; m < 4; ++m) _Pragma("unroll") for (int n = 0; n < 2; ++n) _Pragma("unroll") for (int k = 0; k < 2; ++k) \
        acc[ai][bj][m][n] = __builtin_amdgcn_mfma_f32_16x16x32_bf16(Bt[n][k], At[m][k], acc[ai][bj][m][n], 0, 0, 0); __builtin_amdgcn_s_setprio(0); } while (0)
#define PG8_WAIT_V(n) asm volatile("s_waitcnt vmcnt(" #n ")" ::: "memory")
#define PG8_WAIT_VH(f) do { if (f) { PG8_WAIT_V(8); } else { PG8_WAIT_V(6); } } while (0)
#define PG8_WAIT_L(n) asm volatile("s_waitcnt lgkmcnt(" #n ")" ::: "memory")
#define PG8_BAR __builtin_amdgcn_s_barrier()
#define PG8_SCHED __builtin_amdgcn_sched_barrier(0)
    Unit cur, nxt; int ui = 0;
    if (!S.next(0, cur)) return;
    f32x4 acc[2][2][4][2];
#pragma unroll
    for (int a = 0; a < 2; ++a)
#pragma unroll
        for (int b = 0; b < 2; ++b)
#pragma unroll
            for (int m = 0; m < 4; ++m)
#pragma unroll
                for (int n = 0; n < 2; ++n) acc[a][b][m][n] = (f32x4){0.f, 0.f, 0.f, 0.f};
    bf16x8 At[4][2], B0[2][2], B1[2][2];
    const char* cA = GATHER ? (const char*)g.A : (const char*)g.A + (size_t)cur.pm * tstep + (cur.hs == 2 ? hstep : (size_t)0); size_t chm = cur.hs ? (size_t)0 : hstep, nhm = chm; const char* cB = (const char*)g.Bt + (size_t)cur.pn * tstep;
    if constexpr (GATHER) { PG8_GOFF(gcur, cur); }
    S.a_ready(cur);
    {
        PG8_STAGE(PG8_SB(0, 0), cB, voffB); PG8_STAGE(PG8_SB(0, 1), cB + hstep, voffB); PG8_STAGE_A(PG8_SA(0, 0), cA, 0, gcur, chm); PG8_STAGE_A(PG8_SA(0, 1), cA, 1, gcur, chm);
        if (wr == 1) PG8_BAR;
        PG8_WAIT_V(2); PG8_BAR;
        PG8_STAGE(PG8_SB(1, 0), cB + kstep, voffB); PG8_STAGE_A(PG8_SA(1, 0), cA + kstep, 0, gcur, chm); PG8_STAGE(PG8_SB(1, 1), cB + hstep + kstep, voffB);
        PG8_WAIT_V(6); PG8_BAR;
    }
    for (;;) {
        const bool has_next = S.next(ui + 1, nxt);
        const char* nA = GATHER ? cA : (has_next ? (const char*)g.A + (size_t)nxt.pm * tstep + (nxt.hs == 2 ? hstep : (size_t)0) : cA); nhm = has_next ? (nxt.hs ? (size_t)0 : hstep) : chm; const bool full = (cur.hs == 0); const char* nB = has_next ? (const char*)g.Bt + (size_t)nxt.pn * tstep : cB;
        if constexpr (GATHER) { if (has_next) { PG8_GOFF(gnxt, nxt); } else {
#pragma unroll
            for (int h = 0; h < 2; ++h) { gnxt[h][0] = gcur[h][0]; gnxt[h][1] = gcur[h][1]; } } }
        for (int t = 0; t < nt; t += 2) {
            const bool last = (t == nt - 2);
            const char* a1 = cA + (size_t)(t + 1) * kstep;
            const char* a2 = last ? nA : cA + (size_t)(t + 2) * kstep; const char* b2 = last ? nB : cB + (size_t)(t + 2) * kstep;
            const char* a3 = a2 + kstep; const char* b3 = b2 + kstep;
            unsigned s2[2][2];
#pragma unroll
            for (int h = 0; h < 2; ++h) { s2[h][0] = last ? gnxt[h][0] : gcur[h][0]; s2[h][1] = last ? gnxt[h][1] : gcur[h][1]; }
            const size_t hm2 = last ? nhm : chm; const bool f2 = (hm2 != 0);
            if (last && has_next) S.a_ready(nxt);
            PG8_LDB(B0, 0, 0); PG8_LDB(B1, 0, 1); PG8_SCHED; PG8_LDA(At, 0, 0); if (full) { PG8_STAGE_A(PG8_SA(1, 1), a1, 1, gcur, chm); }
            PG8_WAIT_VH(full); PG8_WAIT_L(0); PG8_BAR; PG8_MMA(0, 0, At, B0); PG8_MMA(0, 1, At, B1); PG8_BAR; PG8_SCHED;
            if (full) { PG8_LDA(At, 0, 1); } PG8_STAGE(PG8_SB(0, 0), b2, voffB); PG8_STAGE(PG8_SB(0, 1), b2 + hstep, voffB); PG8_STAGE_A(PG8_SA(0, 0), a2, 0, s2, hm2);
            PG8_WAIT_VH(full); PG8_WAIT_L(0); PG8_BAR; if (full) { PG8_MMA(1, 0, At, B0); PG8_MMA(1, 1, At, B1); } PG8_BAR; PG8_SCHED;
            PG8_LDB(B0, 1, 0); PG8_LDB(B1, 1, 1); PG8_SCHED; PG8_LDA(At, 1, 0); if (f2) { PG8_STAGE_A(PG8_SA(0, 1), a2, 1, s2, hm2); }
            PG8_WAIT_VH(f2); PG8_WAIT_L(0); PG8_BAR; PG8_MMA(0, 0, At, B0); PG8_MMA(0, 1, At, B1); PG8_BAR; PG8_SCHED;
            if (full) { PG8_LDA(At, 1, 1); } PG8_STAGE(PG8_SB(1, 0), b3, voffB); PG8_STAGE(PG8_SB(1, 1), b3 + hstep, voffB); PG8_STAGE_A(PG8_SA(1, 0), a3, 0, s2, hm2);
            PG8_WAIT_VH(f2); PG8_WAIT_L(0); PG8_BAR; if (full) { PG8_MMA(1, 0, At, B0); PG8_MMA(1, 1, At, B1); } PG8_BAR; PG8_SCHED;
        }
        if constexpr (ALIGN_EPI) { if (wr == 0) PG8_BAR; }
        if constexpr (!Epi::AFTER_DRAIN) { E(acc, cur, wr, wc, fr, fq); S.done(cur); }
        if (!has_next) break;
#pragma unroll
        for (int a = 0; a < 2; ++a)
#pragma unroll
            for (int b = 0; b < 2; ++b)
#pragma unroll
                for (int m = 0; m < 4; ++m)
#pragma unroll
                    for (int n = 0; n < 2; ++n) acc[a][b][m][n] = (f32x4){0.f, 0.f, 0.f, 0.f};
        cur = nxt; cA = nA; cB = nB; chm = nhm; ++ui;
#pragma unroll
        for (int h = 0; h < 2; ++h) { gcur[h][0] = gnxt[h][0]; gcur[h][1] = gnxt[h][1]; }
        if constexpr (ALIGN_EPI) { if (wr == 1) PG8_BAR; }
    }
    PG8_WAIT_V(0);
    if constexpr (!ALIGN_EPI) { if (wr == 0) PG8_BAR; }
    PG8_BAR;
#undef PG8_SA
#undef PG8_SB
#undef PG8_STAGE
#undef PG8_STAGE_A
#undef PG8_GOFF
#undef PG8_LDA
#undef PG8_LDB
#undef PG8_MMA
#undef PG8_WAIT_V
#undef PG8_WAIT_VH
#undef PG8_WAIT_L
#undef PG8_BAR
#undef PG8_SCHED
}
}

namespace att {
using bf16 = __hip_bfloat16;
using bf16x8 = __attribute__((ext_vector_type(8))) short;
using s16x4  = __attribute__((ext_vector_type(4))) short;
using f32x16 = __attribute__((ext_vector_type(16))) float;
using u32x4  = __attribute__((ext_vector_type(4))) unsigned;
constexpr int NW = 8, QBLK = 32, KVBLK = 64;
constexpr float THR = 8.f;
#define SBAR() __builtin_amdgcn_sched_barrier(0)
__device__ __forceinline__ int crow(int r, int hi) { return (r & 3) + 8 * (r >> 2) + 4 * hi; }
__device__ __forceinline__ unsigned cvtpk(float lo, float hi) { unsigned r; asm volatile("v_cvt_pk_bf16_f32 %0, %1, %2" : "=v"(r) : "v"(lo), "v"(hi)); return r; }
typedef __attribute__((address_space(3))) char* lds_p; typedef __attribute__((address_space(3))) const char* lds_cp; typedef __attribute__((address_space(3))) float* lds_fp;
template <int KW> __device__ __forceinline__ int kswz(int row, int cb) {
    if constexpr (KW == 128) return row * 256 + (cb ^ ((row & 15) << 4));
    else return row * 128 + (cb ^ (((row >> 1) & 7) << 4));
}
template <int DV> __device__ __forceinline__ int v_st(int k, int c) { const int kk = k;     return ((kk >> 3) * (DV / 32) + (c >> 5)) * 512 + ((kk & 7) * 32 + (c & 31)) * 2; }
__device__ __forceinline__ int v_rd_base(int lane) { return ((lane & 3) << 3) | (((lane >> 2) & 3) << 6) | (((lane >> 4) & 1) << 5) | (((lane >> 5) & 1) << 8); }
template <int OFF> __device__ __forceinline__ s16x4 tr_read(int vb) { s16x4 r; asm volatile("ds_read_b64_tr_b16 %0, %1 offset:%2" : "=&v"(r) : "v"(vb), "i"(OFF) : "memory"); return r; }

#define MX3(a, b, c) __builtin_fmaxf(__builtin_fmaxf((a), (b)), (c))
__device__ __forceinline__ float rowmax32(const f32x16& p0, const f32x16& p1) {
    float a = MX3(p0[0], p0[1], p1[0]), b = MX3(p0[2], p0[3], p1[1]); a = MX3(a, p1[2], p1[3]);
#pragma unroll
    for (int r = 4; r < 16; r += 4) { a = MX3(a, p0[r], p0[r + 1]); b = MX3(b, p0[r + 2], p0[r + 3]); a = MX3(a, p1[r], p1[r + 1]); b = MX3(b, p1[r + 2], p1[r + 3]); }
    float rm = __builtin_fmaxf(a, b);
    auto rr = __builtin_amdgcn_permlane32_swap(__float_as_uint(rm), __float_as_uint(rm), false, false);
    return __builtin_fmaxf(__uint_as_float(rr[0]), __uint_as_float(rr[1]));
}
#undef MX3
__device__ __forceinline__ void finishSM(f32x16& p0, f32x16& p1, float& l_reg, bf16x8& pa0, bf16x8& pa1, bf16x8& pa2, bf16x8& pa3) {
#pragma unroll
    for (int r = 0; r < 16; ++r) p1[r] = __builtin_amdgcn_exp2f(p1[r]);
    float ps = 0;
#pragma unroll
    for (int r = 0; r < 16; ++r) ps += p0[r];
#pragma unroll
    for (int r = 0; r < 16; ++r) ps += p1[r];
    l_reg += ps;
    u32x4 w0 = {cvtpk(p0[0], p0[1]), cvtpk(p0[2], p0[3]), cvtpk(p0[4], p0[5]), cvtpk(p0[6], p0[7])};
    u32x4 w1 = {cvtpk(p0[8], p0[9]), cvtpk(p0[10], p0[11]), cvtpk(p0[12], p0[13]), cvtpk(p0[14], p0[15])};
    u32x4 w2 = {cvtpk(p1[0], p1[1]), cvtpk(p1[2], p1[3]), cvtpk(p1[4], p1[5]), cvtpk(p1[6], p1[7])};
    u32x4 w3 = {cvtpk(p1[8], p1[9]), cvtpk(p1[10], p1[11]), cvtpk(p1[12], p1[13]), cvtpk(p1[14], p1[15])};
    pa0 = __builtin_bit_cast(bf16x8, w0); pa1 = __builtin_bit_cast(bf16x8, w1); pa2 = __builtin_bit_cast(bf16x8, w2); pa3 = __builtin_bit_cast(bf16x8, w3);
}
template <int KW> __device__ __forceinline__ void qkt(f32x16& p0, f32x16& p1, lds_cp Ks, const bf16x8* qr, const f32x16& c0, const f32x16& c1, int r32, int hi, int kcb) {
#pragma unroll
    for (int d0 = 0; d0 < 4; ++d0) { const int cb = kcb + (d0 * 16 + hi * 8) * 2;
        const bf16x8 b0 = *reinterpret_cast<const __attribute__((address_space(3))) bf16x8*>(Ks + kswz<KW>(r32, cb));
        const bf16x8 b1 = *reinterpret_cast<const __attribute__((address_space(3))) bf16x8*>(Ks + kswz<KW>(32 + r32, cb));
        if (d0 == 0) { p0 = __builtin_amdgcn_mfma_f32_32x32x16_bf16(b0, qr[0], c0, 0, 0, 0); p1 = __builtin_amdgcn_mfma_f32_32x32x16_bf16(b1, qr[0], c1, 0, 0, 0); }
        else { p0 = __builtin_amdgcn_mfma_f32_32x32x16_bf16(b0, qr[d0], p0, 0, 0, 0); p1 = __builtin_amdgcn_mfma_f32_32x32x16_bf16(b1, qr[d0], p1, 0, 0, 0); } }
}
template <int OFF> __device__ __forceinline__ bf16x8 k_read(int addr) { bf16x8 r; asm volatile("ds_read_b128 %0, %1 offset:%2" : "=&v"(r) : "v"(addr), "i"(OFF) : "memory"); return r; }
template <int KW> __device__ __forceinline__ void qkt_batched(f32x16& p0, f32x16& p1, lds_cp Ks, const bf16x8* qr, const f32x16& c0, const f32x16& c1, int r32, int hi, int kcb) {
    constexpr int O2 = 32 * KW * 2;
    const int base = (int)(uintptr_t)Ks;
    const int a0 = base + kswz<KW>(r32, kcb + (0 * 16 + hi * 8) * 2), a1 = base + kswz<KW>(r32, kcb + (1 * 16 + hi * 8) * 2);
    const int a2 = base + kswz<KW>(r32, kcb + (2 * 16 + hi * 8) * 2), a3 = base + kswz<KW>(r32, kcb + (3 * 16 + hi * 8) * 2);
    bf16x8 b0 = k_read<0>(a0), b1 = k_read<O2>(a0), b2 = k_read<0>(a1), b3 = k_read<O2>(a1), b4 = k_read<0>(a2), b5 = k_read<O2>(a2), b6 = k_read<0>(a3), b7 = k_read<O2>(a3);
    asm volatile("s_waitcnt lgkmcnt(6)" : "+v"(b0), "+v"(b1) :: "memory");
    p0 = __builtin_amdgcn_mfma_f32_32x32x16_bf16(b0, qr[0], c0, 0, 0, 0); p1 = __builtin_amdgcn_mfma_f32_32x32x16_bf16(b1, qr[0], c1, 0, 0, 0); SBAR();
    asm volatile("s_waitcnt lgkmcnt(4)" : "+v"(b2), "+v"(b3) :: "memory");
    p0 = __builtin_amdgcn_mfma_f32_32x32x16_bf16(b2, qr[1], p0, 0, 0, 0); p1 = __builtin_amdgcn_mfma_f32_32x32x16_bf16(b3, qr[1], p1, 0, 0, 0); SBAR();
    asm volatile("s_waitcnt lgkmcnt(2)" : "+v"(b4), "+v"(b5) :: "memory");
    p0 = __builtin_amdgcn_mfma_f32_32x32x16_bf16(b4, qr[2], p0, 0, 0, 0); p1 = __builtin_amdgcn_mfma_f32_32x32x16_bf16(b5, qr[2], p1, 0, 0, 0); SBAR();
    asm volatile("s_waitcnt lgkmcnt(0)" : "+v"(b6), "+v"(b7) :: "memory");
    p0 = __builtin_amdgcn_mfma_f32_32x32x16_bf16(b6, qr[3], p0, 0, 0, 0); p1 = __builtin_amdgcn_mfma_f32_32x32x16_bf16(b7, qr[3], p1, 0, 0, 0);
}
template <int KW> __device__ __forceinline__ void qkt_pipe2(f32x16& p0, f32x16& p1, lds_cp Ks, const bf16x8* qr, const f32x16& c0, const f32x16& c1, int r32, int hi, int kcb) {
    constexpr int O2 = 32 * KW * 2;
    const int base = (int)(uintptr_t)Ks;
    const int a0 = base + kswz<KW>(r32, kcb + (0 * 16 + hi * 8) * 2), a1 = base + kswz<KW>(r32, kcb + (1 * 16 + hi * 8) * 2);
    const int a2 = base + kswz<KW>(r32, kcb + (2 * 16 + hi * 8) * 2), a3 = base + kswz<KW>(r32, kcb + (3 * 16 + hi * 8) * 2);
    bf16x8 b0 = k_read<0>(a0), b1 = k_read<O2>(a0), b2 = k_read<0>(a1), b3 = k_read<O2>(a1);
    asm volatile("s_waitcnt lgkmcnt(2)" : "+v"(b0), "+v"(b1) :: "memory");
    p0 = __builtin_amdgcn_mfma_f32_32x32x16_bf16(b0, qr[0], c0, 0, 0, 0); p1 = __builtin_amdgcn_mfma_f32_32x32x16_bf16(b1, qr[0], c1, 0, 0, 0); SBAR();
    b0 = k_read<0>(a2); b1 = k_read<O2>(a2);
    asm volatile("s_waitcnt lgkmcnt(2)" : "+v"(b2), "+v"(b3) :: "memory");
    p0 = __builtin_amdgcn_mfma_f32_32x32x16_bf16(b2, qr[1], p0, 0, 0, 0); p1 = __builtin_amdgcn_mfma_f32_32x32x16_bf16(b3, qr[1], p1, 0, 0, 0); SBAR();
    b2 = k_read<0>(a3); b3 = k_read<O2>(a3);
    asm volatile("s_waitcnt lgkmcnt(2)" : "+v"(b0), "+v"(b1) :: "memory");
    p0 = __builtin_amdgcn_mfma_f32_32x32x16_bf16(b0, qr[2], p0, 0, 0, 0); p1 = __builtin_amdgcn_mfma_f32_32x32x16_bf16(b1, qr[2], p1, 0, 0, 0); SBAR();
    asm volatile("s_waitcnt lgkmcnt(0)" : "+v"(b2), "+v"(b3) :: "memory");
    p0 = __builtin_amdgcn_mfma_f32_32x32x16_bf16(b2, qr[3], p0, 0, 0, 0); p1 = __builtin_amdgcn_mfma_f32_32x32x16_bf16(b3, qr[3], p1, 0, 0, 0);
}
template <int DV, int D0> __device__ __forceinline__ void pv_one(f32x16& od, int vb, bf16x8 pa0, bf16x8 pa1, bf16x8 pa2, bf16x8 pa3) {
    constexpr int KS = (DV / 32) * 1024, HF = (DV / 32) * 512;
    const s16x4 l0 = tr_read<D0 * 512 + 0 * KS>(vb), h0 = tr_read<D0 * 512 + 0 * KS + HF>(vb), l1 = tr_read<D0 * 512 + 1 * KS>(vb), h1 = tr_read<D0 * 512 + 1 * KS + HF>(vb);
    const s16x4 l2 = tr_read<D0 * 512 + 2 * KS>(vb), h2 = tr_read<D0 * 512 + 2 * KS + HF>(vb), l3 = tr_read<D0 * 512 + 3 * KS>(vb), h3 = tr_read<D0 * 512 + 3 * KS + HF>(vb);
    asm volatile("s_waitcnt lgkmcnt(0)" ::: "memory"); SBAR();
#define PK(L, H) (bf16x8){L[0], L[1], L[2], L[3], H[0], H[1], H[2], H[3]}
    od = __builtin_amdgcn_mfma_f32_32x32x16_bf16(pa0, PK(l0, h0), od, 0, 0, 0);
    od = __builtin_amdgcn_mfma_f32_32x32x16_bf16(pa1, PK(l1, h1), od, 0, 0, 0);
    od = __builtin_amdgcn_mfma_f32_32x32x16_bf16(pa2, PK(l2, h2), od, 0, 0, 0);
    od = __builtin_amdgcn_mfma_f32_32x32x16_bf16(pa3, PK(l3, h3), od, 0, 0, 0);
#undef PK
}
struct VF8 { s16x4 l0, h0, l1, h1, l2, h2, l3, h3; };
template <int D0> __device__ __forceinline__ void v_reads128(VF8& f, int vb) {
    constexpr int KS = 4 * 1024, HF = 4 * 512;
    f.l0 = tr_read<D0 * 512 + 0 * KS>(vb); f.h0 = tr_read<D0 * 512 + 0 * KS + HF>(vb); f.l1 = tr_read<D0 * 512 + 1 * KS>(vb); f.h1 = tr_read<D0 * 512 + 1 * KS + HF>(vb);
    f.l2 = tr_read<D0 * 512 + 2 * KS>(vb); f.h2 = tr_read<D0 * 512 + 2 * KS + HF>(vb); f.l3 = tr_read<D0 * 512 + 3 * KS>(vb); f.h3 = tr_read<D0 * 512 + 3 * KS + HF>(vb);
}
__device__ __forceinline__ void v_mfma4(f32x16& od, const VF8& f, bf16x8 pa0, bf16x8 pa1, bf16x8 pa2, bf16x8 pa3) {
#define PK(L, H) (bf16x8){L[0], L[1], L[2], L[3], H[0], H[1], H[2], H[3]}
    od = __builtin_amdgcn_mfma_f32_32x32x16_bf16(pa0, PK(f.l0, f.h0), od, 0, 0, 0);
    od = __builtin_amdgcn_mfma_f32_32x32x16_bf16(pa1, PK(f.l1, f.h1), od, 0, 0, 0);
    od = __builtin_amdgcn_mfma_f32_32x32x16_bf16(pa2, PK(f.l2, f.h2), od, 0, 0, 0);
    od = __builtin_amdgcn_mfma_f32_32x32x16_bf16(pa3, PK(f.l3, f.h3), od, 0, 0, 0);
#undef PK
}
template <int D0> __device__ __forceinline__ void v_reads_lo(VF8& f, int vb) { constexpr int KS = 4 * 1024, HF = 4 * 512;
    f.l0 = tr_read<D0 * 512 + 0 * KS>(vb); f.h0 = tr_read<D0 * 512 + 0 * KS + HF>(vb); f.l1 = tr_read<D0 * 512 + 1 * KS>(vb); f.h1 = tr_read<D0 * 512 + 1 * KS + HF>(vb); }
template <int D0> __device__ __forceinline__ void v_reads_hi(VF8& f, int vb) { constexpr int KS = 4 * 1024, HF = 4 * 512;
    f.l2 = tr_read<D0 * 512 + 2 * KS>(vb); f.h2 = tr_read<D0 * 512 + 2 * KS + HF>(vb); f.l3 = tr_read<D0 * 512 + 3 * KS>(vb); f.h3 = tr_read<D0 * 512 + 3 * KS + HF>(vb); }
#define PK(L, H) (bf16x8){L[0], L[1], L[2], L[3], H[0], H[1], H[2], H[3]}
__device__ __forceinline__ void pv_pipe128(f32x16* o, int vb, bf16x8 pa0, bf16x8 pa1, bf16x8 pa2, bf16x8 pa3) {
    s16x4 al0, ah0, al1, ah1, al2, ah2, al3, ah3, nl0, nh0, nl1, nh1;
    constexpr int KS = 4 * 1024, HF = 4 * 512;
#define RD_LO(D, x0, y0, x1, y1) do { x0 = tr_read<(D) * 512 + 0 * KS>(vb); y0 = tr_read<(D) * 512 + 0 * KS + HF>(vb); x1 = tr_read<(D) * 512 + 1 * KS>(vb); y1 = tr_read<(D) * 512 + 1 * KS + HF>(vb); } while (0)
#define RD_HI(D, x2, y2, x3, y3) do { x2 = tr_read<(D) * 512 + 2 * KS>(vb); y2 = tr_read<(D) * 512 + 2 * KS + HF>(vb); x3 = tr_read<(D) * 512 + 3 * KS>(vb); y3 = tr_read<(D) * 512 + 3 * KS + HF>(vb); } while (0)
#define WAITL(n) do { asm volatile("s_waitcnt lgkmcnt(" #n ")" ::: "memory"); SBAR(); } while (0)
    RD_LO(0, al0, ah0, al1, ah1); RD_HI(0, al2, ah2, al3, ah3); RD_LO(1, nl0, nh0, nl1, nh1);
    WAITL(4);
    o[0] = __builtin_amdgcn_mfma_f32_32x32x16_bf16(pa0, PK(al0, ah0), o[0], 0, 0, 0); o[0] = __builtin_amdgcn_mfma_f32_32x32x16_bf16(pa1, PK(al1, ah1), o[0], 0, 0, 0);
    o[0] = __builtin_amdgcn_mfma_f32_32x32x16_bf16(pa2, PK(al2, ah2), o[0], 0, 0, 0); o[0] = __builtin_amdgcn_mfma_f32_32x32x16_bf16(pa3, PK(al3, ah3), o[0], 0, 0, 0); SBAR();
    RD_HI(1, al2, ah2, al3, ah3); RD_LO(2, al0, ah0, al1, ah1);
    WAITL(8);
    o[1] = __builtin_amdgcn_mfma_f32_32x32x16_bf16(pa0, PK(nl0, nh0), o[1], 0, 0, 0); o[1] = __builtin_amdgcn_mfma_f32_32x32x16_bf16(pa1, PK(nl1, nh1), o[1], 0, 0, 0); SBAR();
    WAITL(4);
    o[1] = __builtin_amdgcn_mfma_f32_32x32x16_bf16(pa2, PK(al2, ah2), o[1], 0, 0, 0); o[1] = __builtin_amdgcn_mfma_f32_32x32x16_bf16(pa3, PK(al3, ah3), o[1], 0, 0, 0); SBAR();
    RD_HI(2, al2, ah2, al3, ah3); RD_LO(3, nl0, nh0, nl1, nh1);
    WAITL(8);
    o[2] = __builtin_amdgcn_mfma_f32_32x32x16_bf16(pa0, PK(al0, ah0), o[2], 0, 0, 0); o[2] = __builtin_amdgcn_mfma_f32_32x32x16_bf16(pa1, PK(al1, ah1), o[2], 0, 0, 0); SBAR();
    WAITL(4);
    o[2] = __builtin_amdgcn_mfma_f32_32x32x16_bf16(pa2, PK(al2, ah2), o[2], 0, 0, 0); o[2] = __builtin_amdgcn_mfma_f32_32x32x16_bf16(pa3, PK(al3, ah3), o[2], 0, 0, 0); SBAR();
    RD_HI(3, al2, ah2, al3, ah3);
    WAITL(4);
    o[3] = __builtin_amdgcn_mfma_f32_32x32x16_bf16(pa0, PK(nl0, nh0), o[3], 0, 0, 0); o[3] = __builtin_amdgcn_mfma_f32_32x32x16_bf16(pa1, PK(nl1, nh1), o[3], 0, 0, 0); SBAR();
    WAITL(0);
    o[3] = __builtin_amdgcn_mfma_f32_32x32x16_bf16(pa2, PK(al2, ah2), o[3], 0, 0, 0); o[3] = __builtin_amdgcn_mfma_f32_32x32x16_bf16(pa3, PK(al3, ah3), o[3], 0, 0, 0);
#undef RD_LO
#undef RD_HI
#undef WAITL
}
#undef PK
__device__ __forceinline__ void pv_both64(f32x16* o, int vb, bf16x8 pa0, bf16x8 pa1, bf16x8 pa2, bf16x8 pa3) {
    constexpr int KS = 2 * 1024, HF = 2 * 512;
    const s16x4 l0 = tr_read<0 * KS>(vb), h0 = tr_read<0 * KS + HF>(vb), l1 = tr_read<1 * KS>(vb), h1 = tr_read<1 * KS + HF>(vb);
    const s16x4 l2 = tr_read<2 * KS>(vb), h2 = tr_read<2 * KS + HF>(vb), l3 = tr_read<3 * KS>(vb), h3 = tr_read<3 * KS + HF>(vb);
    const s16x4 m0 = tr_read<512 + 0 * KS>(vb), g0 = tr_read<512 + 0 * KS + HF>(vb), m1 = tr_read<512 + 1 * KS>(vb), g1 = tr_read<512 + 1 * KS + HF>(vb);
    const s16x4 m2 = tr_read<512 + 2 * KS>(vb), g2 = tr_read<512 + 2 * KS + HF>(vb), m3 = tr_read<512 + 3 * KS>(vb), g3 = tr_read<512 + 3 * KS + HF>(vb);
#define PK(L, H) (bf16x8){L[0], L[1], L[2], L[3], H[0], H[1], H[2], H[3]}
    asm volatile("s_waitcnt lgkmcnt(8)" ::: "memory"); SBAR();
    o[0] = __builtin_amdgcn_mfma_f32_32x32x16_bf16(pa0, PK(l0, h0), o[0], 0, 0, 0); o[0] = __builtin_amdgcn_mfma_f32_32x32x16_bf16(pa1, PK(l1, h1), o[0], 0, 0, 0);
    o[0] = __builtin_amdgcn_mfma_f32_32x32x16_bf16(pa2, PK(l2, h2), o[0], 0, 0, 0); o[0] = __builtin_amdgcn_mfma_f32_32x32x16_bf16(pa3, PK(l3, h3), o[0], 0, 0, 0); SBAR();
    asm volatile("s_waitcnt lgkmcnt(0)" ::: "memory"); SBAR();
    o[1] = __builtin_amdgcn_mfma_f32_32x32x16_bf16(pa0, PK(m0, g0), o[1], 0, 0, 0); o[1] = __builtin_amdgcn_mfma_f32_32x32x16_bf16(pa1, PK(m1, g1), o[1], 0, 0, 0);
    o[1] = __builtin_amdgcn_mfma_f32_32x32x16_bf16(pa2, PK(m2, g2), o[1], 0, 0, 0); o[1] = __builtin_amdgcn_mfma_f32_32x32x16_bf16(pa3, PK(m3, g3), o[1], 0, 0, 0);
#undef PK
}
template <int DV> __device__ __forceinline__ void pv_all(f32x16* o, int vb, bf16x8 pa0, bf16x8 pa1, bf16x8 pa2, bf16x8 pa3) {
    if constexpr (DV == 128) { pv_pipe128(o, vb, pa0, pa1, pa2, pa3); return; }
    pv_one<DV, 0>(o[0], vb, pa0, pa1, pa2, pa3); pv_one<DV, 1>(o[1], vb, pa0, pa1, pa2, pa3);
    if constexpr (DV == 128) { pv_one<DV, 2>(o[2], vb, pa0, pa1, pa2, pa3); pv_one<DV, 3>(o[3], vb, pa0, pa1, pa2, pa3); }
}

struct UnitArgs {
    const bf16* Qw; int ldq;
    const bf16* Kh; const bf16* Vh; int ldk;
    int NT;
    int kcol;
    bf16* Ow; int ldo;
    int na_kr0, na_rq, na_c0; const float* rpb;
    float lam; const float* subg; float oscale;
};
constexpr int NA_TAB_FLOATS = 16 * 128;

template <int DV, int KW, int MODE>
__device__ __forceinline__ void attn_unit(const UnitArgs& a, char* lds, const int tid) {
    constexpr int SHM_V = KVBLK * DV * 2, SHM_K = KVBLK * KW * 2, SLOT = SHM_V + SHM_K;
    constexpr int NS = (DV == 128) ? 4 : 8, PD = NS - 1, PER = DV / 64 + KW / 64, RING = NS * SLOT;
    const int wid = __builtin_amdgcn_readfirstlane(tid >> 6), lane = tid & 63, r32 = lane & 31, hi = lane >> 5;
    const lds_p ldsa = (lds_p)lds;
    lds_fp ws = (lds_fp)(ldsa + RING) + wid * 64; lds_fp li_l = ws; lds_fp al_l = ws + 32;
    lds_fp tab = (lds_fp)(ldsa + RING + NW * 64 * 4);
    float mhat = 0.f, l_reg = 0.f; f32x16 o[DV / 32]; bf16x8 qr[4]; f32x16 negm = f32x16{};
#pragma unroll
    for (int d = 0; d < DV / 32; ++d) o[d] = f32x16{};
    const bf16* Qw = a.Qw + (long)r32 * a.ldq + hi * 8;
#pragma unroll
    for (int d0 = 0; d0 < 4; ++d0) qr[d0] = *reinterpret_cast<const bf16x8*>(Qw + d0 * 16);
    typedef __attribute__((address_space(3))) unsigned lds_u32;
    const int kcb = a.kcol * 2;
    const bf16* Vh = a.Vh; const bf16* Kh = a.Kh; const int ldk = a.ldk;
    unsigned koffA, koffB = 0u, voffA, voffB = 0u;
    { auto ksrc = [&](int ch) -> unsigned { const int p = ch * 1024 + lane * 16; constexpr int RB = KW * 2; const int row = p / RB, slot = (p % RB) >> 4;
          const int c = slot ^ ((KW == 128) ? (row & 15) : ((row >> 1) & 7)); return (unsigned)(row * ldk + c * 8) * 2u; };
      auto vsrc = [&](int ch) -> unsigned { const int p = ch * 1024 + lane * 16; constexpr int NB = DV / 32; const int sub = p >> 9, kkh = sub / NB, cblk = sub % NB, within = p & 511;
          const int key = kkh * 8 + (within >> 6), col = cblk * 32 + ((within & 63) >> 4) * 8; return (unsigned)(key * ldk + col) * 2u; };
      koffA = ksrc(wid); voffA = vsrc(wid); if constexpr (KW == 128) koffB = ksrc(wid + 8); if constexpr (DV == 128) voffB = vsrc(wid + 8); }
    const int vb0 = (int)(uintptr_t)lds + v_rd_base(lane);
    lds_u32* ldsl = (lds_u32*)(__attribute__((address_space(3))) char*)lds;
#define KROW(t) ((MODE == 2) ? (((t) < 4) ? (t) * 64 : (NCTX + (na_kr0 + (t) - 4) * 64)) : (t) * KVBLK)
    const int na_kr0 = a.na_kr0;
#define GLDS(gp_, byteoff_) __builtin_amdgcn_global_load_lds((const unsigned*)(gp_), (lds_u32*)((__attribute__((address_space(3))) char*)ldsl + (byteoff_)), 16, 0, 0)
#define DMA(t_) do { const int k0_ = KROW(t_); const int sl_ = ((t_) % NS) * SLOT; \
    const char* vt_ = (const char*)Vh + (size_t)k0_ * ldk * 2; const char* kt_ = (const char*)Kh + (size_t)k0_ * ldk * 2; \
    const int vd_ = sl_ + wid * 1024, kd_ = sl_ + SHM_V + wid * 1024; \
    GLDS(kt_ + koffA, kd_); if constexpr (KW == 128) GLDS(kt_ + koffB, kd_ + 8192); \
    GLDS(vt_ + voffA, vd_); if constexpr (DV == 128) GLDS(vt_ + voffB, vd_ + 8192); } while (0)
#define KBUF(t_) ((lds_cp)ldsa + (((t_) % NS) * SLOT + SHM_V))
#define VBUF(t_) (vb0 + ((t_) % NS) * SLOT)
    int na_c = 0, na_cs = 0, na_rs = 0;
    if constexpr (MODE == 2) {
        na_c = a.na_c0 + r32; na_cs = na_c - 8; na_cs = na_cs < 0 ? 0 : (na_cs > 48 ? 48 : na_cs);
        na_rs = a.na_rq - 4; na_rs = na_rs < 0 ? 0 : (na_rs > 248 ? 248 : na_rs);
        static_assert(NA_TAB_FLOATS == 4 * 512, "table build: four entries per thread");
        float tv[4];
#pragma unroll
        for (int it = 0; it < 4; ++it) { const int i = tid + 512 * it; const int dri = i >> 7, x = (i & 127) - 48; const bool in_ = (dri < 15) && (x >= 0) && (x < 31);
            const float b = a.rpb[in_ ? dri * 31 + x : 0];
            tv[it] = (dri == 15) ? -INFINITY : (in_ ? b * LOG2E : 0.f); }
#pragma unroll
        for (int it = 0; it < 4; ++it) tab[tid + 512 * it] = tv[it];
    }
    f32x16 cm0 = f32x16{}, cm1 = f32x16{};
#define NA_MASKC() do { const int vb_ = 4 * hi - na_cs; _Pragma("unroll") for (int r = 0; r < 16; ++r) { const int kc_ = (r & 3) + 8 * (r >> 2); \
        cm0[r] = ((unsigned)(vb_ + kc_) < 16u) ? cm0[r] : -INFINITY; cm1[r] = ((unsigned)(vb_ + kc_ + 32) < 16u) ? cm1[r] : -INFINITY; } } while (0)
#define NABIAS(P0, P1, t_) do { const int dri_ = na_kr0 + (t_) - 4 - a.na_rq + 7; const __attribute__((address_space(3))) float* tb_ = tab + dri_ * 128 + (63 - na_c + 4 * hi); \
        _Pragma("unroll") for (int r = 0; r < 16; ++r) { const int kc_ = (r & 3) + 8 * (r >> 2); P0[r] += tb_[kc_]; P1[r] += tb_[kc_ + 32]; } } while (0)
#define PARTIAL(P0, P1, FIRST) do { const float rm_ = rowmax32(P0, P1); const bool fst_ = (FIRST); \
    if (fst_ || __builtin_expect(__any(rm_ > THR), 0)) { const float dl_ = fst_ ? rm_ : __builtin_fmaxf(rm_, 0.f); mhat += dl_; \
        _Pragma("unroll") for (int r = 0; r < 16; ++r) { P0[r] -= dl_; P1[r] -= dl_; } \
        if constexpr (MODE == 2) { _Pragma("unroll") for (int r = 0; r < 16; ++r) { cm0[r] -= dl_; cm1[r] -= dl_; } } else { _Pragma("unroll") for (int r = 0; r < 16; ++r) negm[r] = -mhat; } \
        if (!fst_) { const float f_ = __builtin_amdgcn_exp2f(-dl_); l_reg *= f_; if (hi == 0) al_l[r32] = f_; asm volatile("s_waitcnt lgkmcnt(0)" ::: "memory"); \
            _Pragma("unroll") for (int d = 0; d < DV / 32; ++d) _Pragma("unroll") for (int r = 0; r < 16; ++r) o[d][r] *= al_l[crow(r, hi)]; } } \
    _Pragma("unroll") for (int r = 0; r < 16; ++r) P0[r] = __builtin_amdgcn_exp2f(P0[r]); } while (0)
    f32x16 pA0, pA1, pB0, pB1; bf16x8 pa0, pa1, pa2, pa3; const int NST = a.NT >> 1;
    const bool lead = wid < 4;
    unsigned vmask = 0xffffffffu;
    if constexpr (MODE == 2) { vmask = 0xfu; for (int t = 4; t < 16; ++t) if ((unsigned)(na_kr0 + t - 4 - na_rs) < 8u) vmask |= 1u << t; vmask = (unsigned)__builtin_amdgcn_readfirstlane((int)vmask); }
#define TV(t_) ((MODE != 2) || ((vmask >> (t_)) & 1u))
    const int NT = a.NT;
#define WAITV(n_) asm volatile("s_waitcnt vmcnt(%0)" :: "n"(n_) : "memory")
#define STEPBAR(t_) do { if ((t_) + PD - 1 < NT) { WAITV((PD - 2) * PER); } else { WAITV(0); } asm volatile("s_waitcnt lgkmcnt(0)\n\ts_barrier" ::: "memory"); } while (0)
#define RSTEP(PX0, PX1, PY0, PY1, t_, GRID_) do { const int tt_ = (t_); const bool vx_ = TV(tt_), vy_ = (tt_ + 1 < NT) && TV(tt_ + 1); \
    STEPBAR(tt_); \
    SBAR(); if (!lead && vx_) { PARTIAL(PX0, PX1, tt_ == 0); } SBAR(); \
    if (vy_) { __builtin_amdgcn_s_setprio(1); if constexpr (MODE == 2) { qkt_batched<KW>(PY0, PY1, KBUF(tt_ + 1), qr, cm0, cm1, r32, hi, kcb); } else if constexpr (MODE == 0) { qkt_batched<KW>(PY0, PY1, KBUF(tt_ + 1), qr, negm, negm, r32, hi, kcb); } else { qkt_pipe2<KW>(PY0, PY1, KBUF(tt_ + 1), qr, negm, negm, r32, hi, kcb); } __builtin_amdgcn_s_setprio(0); \
        if constexpr (GRID_) { NABIAS(PY0, PY1, tt_ + 1); } } SBAR(); \
    if (tt_ + PD < NT) { DMA(tt_ + PD); } SBAR();     \
    if (vx_) { finishSM(PX0, PX1, l_reg, pa0, pa1, pa2, pa3); SBAR(); __builtin_amdgcn_s_setprio(1); if constexpr (MODE == 0) { pv_both64(o, VBUF(tt_), pa0, pa1, pa2, pa3); } else { pv_all<DV>(o, VBUF(tt_), pa0, pa1, pa2, pa3); } __builtin_amdgcn_s_setprio(0); } SBAR(); \
    if (lead && vy_) { PARTIAL(PY0, PY1, false); } SBAR(); } while (0)
#pragma unroll
    for (int t = 0; t < PD; ++t) if (t < NT) DMA(t);
    if (NT >= PD) { WAITV((PD - 1) * PER); } else { WAITV(0); }
    asm volatile("s_waitcnt lgkmcnt(0)\n\ts_barrier" ::: "memory");
    if constexpr (MODE == 2) { qkt<KW>(pA0, pA1, KBUF(0), qr, cm0, cm1, r32, hi, kcb); } else { qkt<KW>(pA0, pA1, KBUF(0), qr, negm, negm, r32, hi, kcb); }
    if (lead) { PARTIAL(pA0, pA1, true); }
    if constexpr (MODE == 2) {
        RSTEP(pA0, pA1, pB0, pB1, 0, false); RSTEP(pB0, pB1, pA0, pA1, 1, false); RSTEP(pA0, pA1, pB0, pB1, 2, false); NA_MASKC(); RSTEP(pB0, pB1, pA0, pA1, 3, true);
        for (int t = 4; t < NT; t += 2) { RSTEP(pA0, pA1, pB0, pB1, t, true); RSTEP(pB0, pB1, pA0, pA1, t + 1, true); }
    } else {
        for (int t = 0; t < NT; t += 2) { RSTEP(pA0, pA1, pB0, pB1, t, false); RSTEP(pB0, pB1, pA0, pA1, t + 1, false); }
    }
    asm volatile("s_waitcnt vmcnt(0) lgkmcnt(0)\n\ts_barrier" ::: "memory");
    { auto rr = __builtin_amdgcn_permlane32_swap(__float_as_uint(l_reg), __float_as_uint(l_reg), false, false); l_reg = __uint_as_float(rr[0]) + __uint_as_float(rr[1]); }
    if (hi == 0) li_l[r32] = l_reg; asm volatile("s_waitcnt lgkmcnt(0)" ::: "memory");
    int lane_e = (int)__builtin_amdgcn_mbcnt_hi(~0u, __builtin_amdgcn_mbcnt_lo(~0u, 0u)); asm volatile("" : "+v"(lane_e));
    const int r32e = lane_e & 31, hie = lane_e >> 5;
    float rli[16];
#pragma unroll
    for (int r = 0; r < 16; ++r) rli[r] = __builtin_amdgcn_rcpf(li_l[crow(r, hie)]);
    unsigned short* Owp = (unsigned short*)a.Ow; const unsigned ldo = (unsigned)a.ldo;
    if constexpr (MODE != 1) {
#pragma unroll
        for (int r = 0; r < 16; ++r) { const unsigned orow = (unsigned)crow(r, hie);
#pragma unroll
            for (int d0 = 0; d0 < DV / 32; ++d0) Owp[orow * ldo + (unsigned)(d0 * 32 + r32e)] = (unsigned short)(cvtpk(o[d0][r] * rli[r], 0.f) & 0xffffu); }
    } else {
#pragma unroll
        for (int d = 0; d < DV / 32; ++d)
#pragma unroll
            for (int r = 0; r < 16; ++r) o[d][r] *= rli[r];
        lds_fp X = (lds_fp)ldsa;
        if (wid >= 4) {
#pragma unroll
            for (int d = 0; d < DV / 32; ++d)
#pragma unroll
                for (int r = 0; r < 16; ++r) X[(((wid - 4) * 4 + d) * 16 + r) * 64 + lane_e] = o[d][r];
        }
        __syncthreads();
        if (wid < 4) {
#pragma unroll
            for (int d = 0; d < DV / 32; ++d) {
#pragma unroll
                for (int r = 0; r < 16; ++r) o[d][r] -= a.lam * X[((wid * 4 + d) * 16 + r) * 64 + lane_e];
                asm volatile("" ::: "memory"); }
            float sg[DV / 32];
#pragma unroll
            for (int d = 0; d < DV / 32; ++d) sg[d] = a.subg[d * 32 + r32e] * a.oscale;
#pragma unroll
            for (int r = 0; r < 16; ++r) { float ss = 0.f;
#pragma unroll
                for (int d = 0; d < DV / 32; ++d) ss += o[d][r] * o[d][r];
                ss += __shfl_xor(ss, 1); ss += __shfl_xor(ss, 2); ss += __shfl_xor(ss, 4); ss += __shfl_xor(ss, 8); ss += __shfl_xor(ss, 16);
                const float rn = __builtin_amdgcn_rsqf(ss * (1.f / 128.f) + 1e-6f); const unsigned orow = (unsigned)crow(r, hie);
#pragma unroll
                for (int d = 0; d < DV / 32; ++d) Owp[orow * ldo + (unsigned)(d * 32 + r32e)] = (unsigned short)(cvtpk(o[d][r] * rn * sg[d], 0.f) & 0xffffu); }
        }
        __syncthreads();
    }
#undef KROW
#undef GLDS
#undef DMA
#undef KBUF
#undef VBUF
#undef NABIAS
#undef NA_MASKC
#undef PARTIAL
#undef TV
#undef WAITV
#undef STEPBAR
#undef RSTEP
}
#undef SBAR
constexpr int ATT_LDS_MAX = 4 * (64 * 128 * 2 * 2) + NW * 64 * 4 + NA_TAB_FLOATS * 4;
}

constexpr int NWAVES = 8;
constexpr size_t MiB = 1u << 20;
constexpr size_t WS_CTL = 0, CTL_ZERO_BYTES = 1 * MiB;
constexpr size_t WS_MODV = 1 * MiB;
constexpr size_t WS_ROPE = 1 * MiB + 256 * 1024;
constexpr size_t WS_ROUTE = 2 * MiB;
constexpr size_t WS_ROWTOK = 3 * MiB;
constexpr size_t WS_ROWW = 3 * MiB + 256 * 1024;
constexpr size_t WS_TILEEXP = 3 * MiB + 512 * 1024;
constexpr size_t WS_WINE = 4 * MiB, WS_WOUTE = 13 * MiB, WS_WINO = 17 * MiB, WS_WOUTO = 29 * MiB, WS_W13 = 33 * MiB, WS_W2 = 289 * MiB;
constexpr size_t WS_X = 417 * MiB, WS_HB = 482 * MiB, WS_QKV = 515 * MiB, WS_AS = WS_QKV, WS_ELIST = WS_QKV, WS_EWT = WS_QKV + 4 * MiB, WS_AO = 613 * MiB, WS_MIX = 646 * MiB, WS_HMID = WS_AO, WS_Y = 679 * MiB, WS_END = 744 * MiB;
static_assert(WS_X + (size_t)M * D * 4 <= WS_HB && WS_HB + (size_t)M * D * 2 <= WS_QKV && WS_QKV + (size_t)M * ODD_IN * 2 <= WS_AO && WS_AS + (size_t)AS_ROWS * D * 2 <= WS_AO, "ws map 1");
static_assert(WS_AO + (size_t)M * D * 2 <= WS_MIX && WS_MIX + (size_t)M * D * 2 <= WS_Y && WS_HMID + (size_t)AS_ROWS * DE * 2 <= WS_Y && WS_Y + (size_t)2 * M * D * 2 <= WS_END, "ws map 2");
static_assert(WS_W13 + (size_t)DEPTH * NE * 1024 * 1024 * 2 <= WS_W2 && WS_W2 + (size_t)DEPTH * NE * 1024 * 512 * 2 <= WS_X, "ws map 3");
constexpr int CW_TMO = 0, CW_CODE = 1, CW_BAR = 4096, CW_CNT = 16384;
constexpr int LDS_BYTES = 163840, MISC_OFF = LDS_BYTES - 256;
constexpr int RT_BYTES = 36 * 1024 * 4;
constexpr int LN1_MAXREC = 192;
constexpr int MOE_TAB_OFF = 131072;
static_assert(RT_BYTES + 2048 + 512 + LN1_MAXREC * 16 <= MISC_OFF && att::ATT_LDS_MAX <= MISC_OFF && pg8::STAGE_BYTES <= MISC_OFF, "LDS map");

#define LAS __attribute__((address_space(3)))
typedef unsigned short bf16;
typedef unsigned v4u __attribute__((ext_vector_type(4)));
typedef unsigned v2u __attribute__((ext_vector_type(2)));
typedef float v2f __attribute__((ext_vector_type(2)));
typedef float f32x4 __attribute__((ext_vector_type(4)));
#define RLX_AGENT __ATOMIC_RELAXED, __HIP_MEMORY_SCOPE_AGENT
#define LDS_WAIT() asm volatile("s_waitcnt lgkmcnt(0)" ::: "memory")
#define VM_WAIT() asm volatile("s_waitcnt vmcnt(0)" ::: "memory")
__device__ __forceinline__ unsigned f2bf(float f) { unsigned u = __builtin_bit_cast(unsigned, f); return (u + 0x7fffu + ((u >> 16) & 1u)) >> 16; }
__device__ __forceinline__ unsigned pk2(float lo, float hi) { unsigned r; asm("v_cvt_pk_bf16_f32 %0, %1, %2" : "=v"(r) : "v"(lo), "v"(hi)); return r; }
__device__ __forceinline__ float bf_lo(unsigned w) { return __builtin_bit_cast(float, w << 16); }
__device__ __forceinline__ float bf_hi(unsigned w) { return __builtin_bit_cast(float, w & 0xffff0000u); }
__device__ __forceinline__ unsigned pkh2(float lo, float hi) { return (unsigned)__builtin_bit_cast(unsigned short, (_Float16)lo) | ((unsigned)__builtin_bit_cast(unsigned short, (_Float16)hi) << 16); }
__device__ __forceinline__ float h_lo(unsigned w) { return (float)__builtin_bit_cast(_Float16, (unsigned short)(w & 0xffffu)); }
__device__ __forceinline__ float h_hi(unsigned w) { return (float)__builtin_bit_cast(_Float16, (unsigned short)(w >> 16)); }

#define XB_TMO      128
#define XB_XCNT(j)  (256  + 64 * (j))
#define XB_XSUB(j)  (1280 + 64 * (j))
#define XB_XGEN(j)  (2304 + 64 * (j))
#define XB_TOP      3328
#define XB_TOPGEN   3392
#define XCD_BAR_WORDS 3456
#define XB_SPIN_CAP (1u << 21)
__device__ __forceinline__ unsigned xb_ld(unsigned* p)              { return __hip_atomic_load(p, __ATOMIC_RELAXED, __HIP_MEMORY_SCOPE_AGENT); }
__device__ __forceinline__ unsigned xb_add(unsigned* p, unsigned v) { return __hip_atomic_fetch_add(p, v, __ATOMIC_RELAXED, __HIP_MEMORY_SCOPE_AGENT); }
__device__ __forceinline__ unsigned xb_xcc_id() { return (unsigned)__builtin_amdgcn_s_getreg((3 << 11) | 20) & 0xFu; }
#define XB_SPIN(cond, bar) do { unsigned _sp = 0; while (cond) { __builtin_amdgcn_s_sleep(1); \
    if ((++_sp & 255u) == 0u) { if (xb_ld(&(bar)[XB_TMO])) break; if (_sp > XB_SPIN_CAP) { atomicAdd(&(bar)[XB_TMO], 1u); break; } } } } while (0)
struct XcdBarrier { unsigned* bar; unsigned x; volatile LAS unsigned* st; };
__device__ __forceinline__ XcdBarrier xcd_barrier_post(unsigned* bar, volatile LAS unsigned* st) {
    XcdBarrier b; b.bar = bar; b.x = xb_xcc_id(); b.st = st;
    if (threadIdx.x == 0) (void)xb_add(&bar[XB_XCNT(b.x)], 1u);
    return b;
}
__device__ __forceinline__ void xcd_barrier_complete(unsigned* bar, unsigned x, unsigned& nloc, unsigned& nx) {
    const unsigned G = gridDim.x * gridDim.y * gridDim.z;
    unsigned sum, cnt, mine, sp = 0u;
    for (;;) {
        sum = 0u; cnt = 0u; mine = 0u;
#pragma unroll
        for (unsigned j = 0; j < 16; ++j) { const unsigned c = xb_ld(&bar[XB_XCNT(j)]); sum += c; cnt += (c > 0u) ? 1u : 0u; mine = (j == x) ? c : mine; }
        if (sum == G) break;
        __builtin_amdgcn_s_sleep(1);
        if ((++sp & 255u) == 0u) { if (xb_ld(&bar[XB_TMO])) break; if (sp > XB_SPIN_CAP) { atomicAdd(&bar[XB_TMO], 1u); break; } }
    }
    nloc = mine > 0u ? mine : 1u; nx = cnt > 0u ? cnt : 1u;
}
__device__ __forceinline__ void xcd_barrier(const XcdBarrier& b) {
    asm volatile("s_waitcnt vmcnt(0)" ::: "memory");
    __syncthreads();
    if (threadIdx.x == 0) {
        unsigned* bar = b.bar;
        __builtin_amdgcn_s_waitcnt(0);
        unsigned nloc = b.st[0], nx = b.st[1];
        if (nloc == 0u) { xcd_barrier_complete(bar, b.x, nloc, nx); b.st[0] = nloc; b.st[1] = nx; }
        const unsigned old = xb_add(&bar[XB_XSUB(b.x)], 1u);
        const unsigned gen = old / nloc;
        if (old + 1u == (gen + 1u) * nloc) {
            __builtin_amdgcn_fence(__ATOMIC_RELEASE, "agent");
            asm volatile("s_waitcnt vmcnt(0)" ::: "memory");
            const unsigned og = xb_add(&bar[XB_TOP], 1u);
            const unsigned tg = og / nx;
            if (og + 1u == (tg + 1u) * nx) xb_add(&bar[XB_TOPGEN], 1u);
            else XB_SPIN(xb_ld(&bar[XB_TOPGEN]) == tg, bar);
            __builtin_amdgcn_fence(__ATOMIC_ACQUIRE, "agent");
            xb_add(&bar[XB_XGEN(b.x)], 1u);
            asm volatile("s_waitcnt vmcnt(0)" ::: "memory");
        } else {
            XB_SPIN(xb_ld(&bar[XB_XGEN(b.x)]) == gen, bar);
            __builtin_amdgcn_fence(__ATOMIC_ACQUIRE, "agent");
            asm volatile("s_waitcnt vmcnt(0)" ::: "memory");
        }
    }
    __syncthreads();
}

__device__ __forceinline__ int launder_i(int v) { asm volatile("" : "+v"(v)); return __builtin_amdgcn_readfirstlane(v); }
template <class T> __device__ __forceinline__ T* launder_p(T* p) { const unsigned long long v = (unsigned long long)p; unsigned lo = (unsigned)v, hi = (unsigned)(v >> 32);
    asm volatile("" : "+v"(lo), "+v"(hi)); lo = (unsigned)__builtin_amdgcn_readfirstlane((int)lo); hi = (unsigned)__builtin_amdgcn_readfirstlane((int)hi); return (T*)(((unsigned long long)hi << 32) | lo); }
struct Args { const float* in[21]; float* out; unsigned char* ws; int ph_lo, ph_hi; };
enum { I_X = 0, I_C, I_CTX, I_CCTX, I_WMOD, I_BMOD, I_LNG, I_LNB, I_WINE, I_WOUTE, I_DLAM, I_SUBG, I_QKG, I_WINO, I_WOUTO, I_RPB, I_RG, I_RE, I_W1, I_W3, I_W2 };

struct Frame {
    LAS unsigned char* lds; unsigned char* ldsg; unsigned char* ws;
    int tid, lane, wave, vcu, G, gw, NGW, bx;
    const float* const* in;
};
__device__ __forceinline__ float wave_sum(float v) {
#pragma unroll
    for (int o = 1; o < 64; o <<= 1) v += __shfl_xor(v, o);
    return v;
}
__device__ __forceinline__ const float* modv(const Frame& F, int l, int s, int v) { return (const float*)(F.ws + WS_MODV) + ((size_t)(l * 2 + s) * 6 + v) * D; }
__device__ __forceinline__ const float* xrow_in(const Frame& F, int l, int r) {
    return (r < NCTX) ? F.in[I_CTX] + (size_t)r * D : F.in[I_X] + (size_t)(r - NCTX) * D;
}

__device__ __forceinline__ void transpose_item(const float* W, int K, int N, bf16* WT, int k0, int n0, int dst_row0, LAS float* scr, int lane) {
#pragma unroll 8
    for (int i = 0; i < 32; ++i) { const int kk = 2 * i + (lane >> 5); scr[kk * 33 + (lane & 31)] = W[(size_t)(k0 + kk) * N + n0 + (lane & 31)]; }
    LDS_WAIT(); asm volatile("" ::: "memory");
    const int c = lane & 7;
#pragma unroll
    for (int j = 0; j < 4; ++j) { const int n = (lane >> 3) + 8 * j; const LAS float* s = scr + (8 * c) * 33 + n;
        v4u o; o.x = pk2(s[0 * 33], s[1 * 33]); o.y = pk2(s[2 * 33], s[3 * 33]); o.z = pk2(s[4 * 33], s[5 * 33]); o.w = pk2(s[6 * 33], s[7 * 33]);
        *(v4u*)(WT + (size_t)(dst_row0 + n) * K + k0 + 8 * c) = o; }
    LDS_WAIT(); asm volatile("" ::: "memory");
}
__device__ __forceinline__ void p0a(Frame& F) {
#ifndef DBG_P0
#define DBG_P0 7
#endif
    if (DBG_P0 & 1) {
        LAS float* sv = (LAS float*)F.lds;
        LAS float* red = (LAS float*)(F.lds + 8192);
        for (int k = F.tid; k < D; k += 512) { const float a = F.in[I_C][k], b = F.in[I_CCTX][k];
            sv[k] = a / (1.f + expf(-a)); sv[D + k] = b / (1.f + expf(-b)); }
        __syncthreads();
        for (int grp = F.bx; grp < DEPTH * 192; grp += F.G) {
            const int l = grp / 192, col = (grp % 192) * 32 + (F.lane & 31), kh = F.lane >> 5;
            const float* W = F.in[I_WMOD] + ((size_t)l * D + F.wave * 128 + kh * 64) * (6 * D) + col;
            float a0 = 0.f, a1 = 0.f;
#pragma unroll 16
            for (int kk = 0; kk < 64; ++kk) { const float w = W[(size_t)kk * (6 * D)]; a0 += sv[F.wave * 128 + kh * 64 + kk] * w; a1 += sv[D + F.wave * 128 + kh * 64 + kk] * w; }
            a0 += __shfl_xor(a0, 32); a1 += __shfl_xor(a1, 32);
            if (F.lane < 32) { red[(F.wave * 64 + F.lane) * 2 + 0] = a0; red[(F.wave * 64 + F.lane) * 2 + 1] = a1; }
            __syncthreads();
            if (F.wave == 0 && F.lane < 32) { float s0 = 0.f, s1 = 0.f;
#pragma unroll
                for (int w = 0; w < 8; ++w) { s0 += red[(w * 64 + F.lane) * 2 + 0]; s1 += red[(w * 64 + F.lane) * 2 + 1]; }
                const float bm = F.in[I_BMOD][(size_t)l * 6 * D + col];
                float* mv = (float*)(F.ws + WS_MODV);
                mv[((size_t)(l * 2 + 0) * 6) * D + col] = s0 + bm; mv[((size_t)(l * 2 + 1) * 6) * D + col] = s1 + bm; }
            __syncthreads();
        }
    }
    if (DBG_P0 & 2) { const int gt = F.bx * 512 + F.tid;
      if (gt < 256 * 16) { const int pos = gt >> 4, i = gt & 15; const double inv = pow(10000.0, -(double)i / 16.0), ang = (double)pos * inv;
          float* rt = (float*)(F.ws + WS_ROPE); rt[gt * 2 + 0] = (float)cos(ang); rt[gt * 2 + 1] = (float)sin(ang); } }
    LAS float* scr = (LAS float*)(F.lds + 16384 + F.wave * 8704);
    constexpr int I_INE = 16 * 72, I_OUT = 16 * 32, I_INO = 16 * 96, T_W1 = 16 * 16, T_W2 = 8 * 32;
    constexpr int N_A = 2 * I_INE, N_B = N_A + 2 * I_OUT, N_C = N_B + 2 * I_INO, N_D = N_C + 2 * I_OUT, N_E = N_D + 128 * T_W1, N_F = N_E + 128 * T_W1, N_G = N_F + 128 * T_W2;
    if (DBG_P0 & 4) for (int it = F.gw; it < N_G; it += F.NGW) {
        if (it < N_A) { const int i = it / I_INE, r = it % I_INE, kb = r / 72, nb = r % 72;
            transpose_item(F.in[I_WINE] + (size_t)i * D * EVEN_IN, D, EVEN_IN, (bf16*)(F.ws + WS_WINE) + (size_t)i * EVEN_IN * D, 64 * kb, 32 * nb, 32 * nb, scr, F.lane); }
        else if (it < N_B) { const int q = it - N_A, i = q / I_OUT, r = q % I_OUT, kb = r / 32, nb = r % 32;
            transpose_item(F.in[I_WOUTE] + (size_t)i * D * D, D, D, (bf16*)(F.ws + WS_WOUTE) + (size_t)i * D * D, 64 * kb, 32 * nb, 32 * nb, scr, F.lane); }
        else if (it < N_C) { const int q = it - N_B, i = q / I_INO, r = q % I_INO, kb = r / 96, nb = r % 96;
            transpose_item(F.in[I_WINO] + (size_t)i * D * ODD_IN, D, ODD_IN, (bf16*)(F.ws + WS_WINO) + (size_t)i * ODD_IN * D, 64 * kb, 32 * nb, 32 * nb, scr, F.lane); }
        else if (it < N_D) { const int q = it - N_C, i = q / I_OUT, r = q % I_OUT, kb = r / 32, nb = r % 32;
            transpose_item(F.in[I_WOUTO] + (size_t)i * D * D, D, D, (bf16*)(F.ws + WS_WOUTO) + (size_t)i * D * D, 64 * kb, 32 * nb, 32 * nb, scr, F.lane); }
        else if (it < N_F) { const bool is3 = it >= N_E; const int q = it - (is3 ? N_E : N_D), le = q / T_W1, r = q % T_W1, kb = r / 16, nb = r % 16, n0 = 32 * nb;
            transpose_item(F.in[is3 ? I_W3 : I_W1] + (size_t)le * D * DE, D, DE, (bf16*)(F.ws + WS_W13) + (size_t)le * 1024 * D, 64 * kb, n0, (n0 >> 7) * 256 + (is3 ? 128 : 0) + (n0 & 127), scr, F.lane); }
        else { const int q = it - N_F, le = q / T_W2, r = q % T_W2, kb = r / 32, nb = r % 32;
            transpose_item(F.in[I_W2] + (size_t)le * DE * D, DE, D, (bf16*)(F.ws + WS_W2) + (size_t)le * D * DE, 64 * kb, 32 * nb, 32 * nb, scr, F.lane); }
    }
}
__device__ __forceinline__ void p0b(Frame& F) {
    f32x4 xn[2][4];
#define P0B_LOAD(b_, r_) do { const f32x4* xr_ = (const f32x4*)xrow_in(F, 0, (r_)) + F.lane; _Pragma("unroll") for (int j = 0; j < 4; ++j) xn[b_][j] = xr_[64 * j]; } while (0)
#pragma unroll 1
    for (int pass = 0; pass < 2; ++pass) {
        const int s = 1 - pass;
        const int rfirst = pass ? NCTX + F.gw : (F.wave == 0 ? F.vcu : NCTX), rstep = pass ? F.NGW : F.G, rend = pass ? M : NCTX;
        if (rfirst >= rend) continue;
        f32x4 psc[4], psh[4];
        { const f32x4* sh = (const f32x4*)modv(F, 0, s, 0) + F.lane; const f32x4* sc = (const f32x4*)modv(F, 0, s, 1) + F.lane;
#pragma unroll
          for (int j = 0; j < 4; ++j) { psc[j] = sc[64 * j] + 1.f; psh[j] = sh[64 * j]; } }
        P0B_LOAD(0, rfirst); if (rfirst + rstep < rend) P0B_LOAD(1, rfirst + rstep);
#pragma unroll 1
        for (int row2 = rfirst; row2 < rend; row2 += 2 * rstep) {
#pragma unroll
            for (int pb = 0; pb < 2; ++pb) { const int row = row2 + pb * rstep; if (row < rend) {
                f32x4 x[4];
#pragma unroll
                for (int j = 0; j < 4; ++j) x[j] = xn[pb][j];
                asm volatile("" ::: "memory");
                { const int nrow = row + 2 * rstep; if (nrow < rend) P0B_LOAD(pb, nrow); }
                asm volatile("" ::: "memory");
                v2u* o = (v2u*)((bf16*)(F.ws + WS_HB) + (size_t)row * D) + F.lane; v2u* xo = (v2u*)((unsigned short*)(F.ws + WS_X) + (size_t)row * D) + F.lane;
#pragma unroll
                for (int j = 0; j < 4; ++j) { const f32x4 h = x[j] * psc[j] + psh[j];
                    { v2u w; w.x = pkh2(x[j].x, x[j].y); w.y = pkh2(x[j].z, x[j].w); xo[64 * j] = w; }
                    v2u w; w.x = pk2(h.x, h.y); w.y = pk2(h.z, h.w); o[64 * j] = w; }
            } }
        }
    }
#undef P0B_LOAD
}
__device__ __forceinline__ void qkpost(Frame& F, int i, bool dry = false) {
    bf16* QKV = (bf16*)(F.ws + WS_QKV);
    const float* rt = (const float*)(F.ws + WS_ROPE);
    const int j = F.lane & 7;
    float g0[8], g1[8];
#pragma unroll
    for (int e = 0; e < 8; ++e) { g0[e] = F.in[I_QKG][(size_t)(i * 2 + 0) * 64 + 8 * j + e]; g1[e] = F.in[I_QKG][(size_t)(i * 2 + 1) * 64 + 8 * j + e]; }
#define QK_COL(vec_, col_, kind_) do { if ((vec_) < 8) { col_ = (vec_) * 64; kind_ = 4; } else if ((vec_) < 16) { col_ = 512 + ((vec_) - 8) * 64; kind_ = 0; } \
        else if ((vec_) < 24) { col_ = 1536 + ((vec_) - 16) * 64; kind_ = 5; } else { col_ = 2048 + ((vec_) - 24) * 64; kind_ = 2; } } while (0)
    v4u wn[4]; v2f rn_[8];
#define QK_LOAD(r_) do { const int t_ = (r_) - NCTX; const int pos_ = (j < 4) ? (t_ >> 6) : (t_ & 63); \
        _Pragma("unroll") for (int it = 0; it < 4; ++it) { const int vec = it * 8 + (F.lane >> 3); int col, kind; QK_COL(vec, col, kind); (void)kind; \
            wn[it] = v4u{0u, 0u, 0u, 0u}; if (vec < 26) wn[it] = *(const v4u*)(QKV + (size_t)(r_) * EVEN_IN + col + 8 * j); } \
        _Pragma("unroll") for (int e = 0; e < 8; ++e) rn_[e] = v2f{1.f, 0.f}; \
        if ((r_) >= NCTX) { _Pragma("unroll") for (int e = 0; e < 8; ++e) rn_[e] = *(const v2f*)(rt + (pos_ * 16 + 8 * (j & 1) + e) * 2); } } while (0)
    if (F.gw < M) QK_LOAD(F.gw);
#pragma unroll 1
    for (int row = F.gw; row < M; row += F.NGW) {
        v4u wc[4]; float cs[8], sn[8];
#pragma unroll
        for (int it = 0; it < 4; ++it) wc[it] = wn[it];
#pragma unroll
        for (int e = 0; e < 8; ++e) { cs[e] = rn_[e].x; sn[e] = rn_[e].y; }
        asm volatile("" ::: "memory");
        { const int nrow = row + F.NGW; if (nrow < M) QK_LOAD(nrow); }
        asm volatile("" ::: "memory");
        const float sgn = (j & 2) ? 1.f : -1.f;
#pragma unroll
        for (int it = 0; it < 4; ++it) {
            const int vec = it * 8 + (F.lane >> 3); const bool act = vec < 26;
            int col; int kind; QK_COL(vec, col, kind);
            v4u* p = (v4u*)(QKV + (size_t)row * EVEN_IN + col + 8 * j);
            const v4u w = wc[it];
            float x[8] = {bf_lo(w.x), bf_hi(w.x), bf_lo(w.y), bf_hi(w.y), bf_lo(w.z), bf_hi(w.z), bf_lo(w.w), bf_hi(w.w)};
            float ss = 0.f;
#pragma unroll
            for (int e = 0; e < 8; ++e) ss += x[e] * x[e];
            ss += __shfl_xor(ss, 1); ss += __shfl_xor(ss, 2); ss += __shfl_xor(ss, 4);
            if (kind & 3) { const float rn = 1.0f / sqrtf(ss * (1.f / 64.f) + 1e-6f);
#pragma unroll
                for (int e = 0; e < 8; ++e) x[e] = x[e] * rn * ((kind & 1) ? g0[e] : g1[e]); }
            const float scl = (kind & 4) ? C2 : 1.f;
            float y[8];
#pragma unroll
            for (int e = 0; e < 8; ++e) { const float pr = __shfl_xor(x[e], 2); y[e] = (x[e] * cs[e] + sgn * pr * sn[e]) * scl; }
            if (act) { v4u o; o.x = pk2(y[0], y[1]); o.y = pk2(y[2], y[3]); o.z = pk2(y[4], y[5]); o.w = pk2(y[6], y[7]); *(dry ? (v4u*)((bf16*)(F.ws + WS_Y) + (size_t)row * EVEN_IN + col + 8 * j) : p) = o; }
        }
    }
#undef QK_LOAD
#undef QK_COL
}
__device__ __forceinline__ void ln1_phase(Frame& F, int l, bool last, bool dry = false) {
    LAS f32x4* RT = (LAS f32x4*)F.lds;
    if (F.tid < 96) ((LAS int*)(F.lds + RT_BYTES + 2048))[F.tid] = 0;
    const float* rg = F.in[I_RG] + (size_t)l * D * 4; const float* re = F.in[I_RE] + (size_t)l * D * 32;
    { f32x4 tmp[18];
#pragma unroll
      for (int it = 0; it < 18; ++it) { const int idx = F.tid + 512 * it; const int ln = idx & 63, q = (idx >> 6) % 9, ji = idx / (64 * 9); const int k = 4 * ln + 256 * (ji >> 2) + (ji & 3);
          tmp[it] = (q == 0) ? *(const f32x4*)(rg + (size_t)k * 4) : *(const f32x4*)(re + (size_t)k * 32 + 4 * (q - 1)); }
#pragma unroll
      for (int it = 0; it < 18; ++it) RT[F.tid + 512 * it] = tmp[it]; }
    __syncthreads();
    LAS float* lgs = (LAS float*)(F.lds + RT_BYTES) + F.wave * 64;
    LAS int* lcnt = (LAS int*)(F.lds + RT_BYTES + 2048);
    LAS int* recs = (LAS int*)(F.lds + RT_BYTES + 2048 + 512);
    unsigned* cnt = (unsigned*)(F.ws + WS_CTL) + CW_CNT + l * 32 * 32;
    int* elist = (int*)(F.ws + WS_ELIST); float* ewt = (float*)(F.ws + WS_EWT);
    const float* lng = F.in[I_LNG] + (size_t)(l * 2 + 0) * D; const float* lnb = F.in[I_LNB] + (size_t)(l * 2 + 0) * D;
    v2u xh[2][4], mn[2][4];
    const unsigned short* X16 = (const unsigned short*)(F.ws + WS_X);
#define LN1_LOAD(b_, r_) do { const v2u* mr_ = (const v2u*)((const bf16*)(F.ws + WS_MIX) + (size_t)(r_) * D) + F.lane; const v2u* xr_ = (const v2u*)(X16 + (size_t)(r_) * D) + F.lane; \
        _Pragma("unroll") for (int j = 0; j < 4; ++j) { xh[b_][j] = xr_[64 * j]; mn[b_][j] = mr_[64 * j]; } } while (0)
#pragma unroll 1
    for (int pass = last ? 1 : 0; pass < 2; ++pass) {
    const int s = 1 - pass;
    const int rfirst = pass ? NCTX + F.gw : (F.wave == 0 ? F.vcu : NCTX), rstep = pass ? F.NGW : F.G, rend = pass ? M : NCTX;
    if (rfirst >= rend) continue;
    f32x4 pg1[4], plg[4], plb[4], psc[4], psh[4];
    { const f32x4* g1 = (const f32x4*)modv(F, l, s, 2) + F.lane; const f32x4* sc2 = (const f32x4*)modv(F, l, s, 4) + F.lane; const f32x4* sh2 = (const f32x4*)modv(F, l, s, 3) + F.lane;
#pragma unroll
      for (int j = 0; j < 4; ++j) { pg1[j] = g1[64 * j]; plg[j] = ((const f32x4*)lng)[F.lane + 64 * j]; plb[j] = ((const f32x4*)lnb)[F.lane + 64 * j]; psc[j] = sc2[64 * j] + 1.f; psh[j] = sh2[64 * j]; } }
    LN1_LOAD(0, rfirst); if (rfirst + rstep < rend) LN1_LOAD(1, rfirst + rstep);
#pragma unroll 1
    for (int row2 = rfirst; row2 < rend; row2 += 2 * rstep) {
#pragma unroll
    for (int pb = 0; pb < 2; ++pb) { const int row = row2 + pb * rstep; if (row < rend) {
        f32x4 v[4]; float sm = 0.f, sq = 0.f;
#pragma unroll
        for (int j = 0; j < 4; ++j) { const f32x4 x = {h_lo(xh[pb][j].x), h_hi(xh[pb][j].x), h_lo(xh[pb][j].y), h_hi(xh[pb][j].y)}; const f32x4 g = pg1[j]; const v2u m = mn[pb][j];
            const f32x4 mx = {bf_lo(m.x), bf_hi(m.x), bf_lo(m.y), bf_hi(m.y)};
            v[j] = x * DN_ALPHA + g * mx; sm += (v[j].x + v[j].y) + (v[j].z + v[j].w); sq += (v[j].x * v[j].x + v[j].y * v[j].y) + (v[j].z * v[j].z + v[j].w * v[j].w); }
#pragma unroll
        for (int o = 1; o < 64; o <<= 1) { sm += __shfl_xor(sm, o); sq += __shfl_xor(sq, o); }
        const float mean = sm * (1.f / D); const float rstd = 1.0f / sqrtf(fmaxf(sq * (1.f / D) - mean * mean, 0.f) + LN_EPS);
        asm volatile("" ::: "memory");
        { const int nrow = row + 2 * rstep; if (nrow < rend) LN1_LOAD(pb, nrow); }
        asm volatile("" ::: "memory");
        v2u* xo = (v2u*)((unsigned short*)(F.ws + (dry ? WS_Y : WS_X)) + (size_t)row * D) + F.lane;
        v2u* ho = (v2u*)((bf16*)(F.ws + (dry ? WS_AO : WS_HB)) + (size_t)row * D) + F.lane;
        const LAS f32x4* RTl = RT + F.lane;
        float ag[4] = {0.f, 0.f, 0.f, 0.f};
#pragma unroll
        for (int j = 0; j < 4; ++j) {
            const f32x4 y = (v[j] - mean) * rstd * plg[j] + plb[j];
            const f32x4 h = y * psc[j] + psh[j];
            { v2u w; w.x = pkh2(y.x, y.y); w.y = pkh2(y.z, y.w); xo[64 * j] = w; } { v2u w; w.x = pk2(h.x, h.y); w.y = pk2(h.z, h.w); ho[64 * j] = w; }
            v[j] = h;
#pragma unroll
            for (int i = 0; i < 4; ++i) { const f32x4 wv = RTl[((j * 4 + i) * 9) * 64]; ag[0] += h[i] * wv.x; ag[1] += h[i] * wv.y; ag[2] += h[i] * wv.z; ag[3] += h[i] * wv.w; } }
        float lg0, lg1, lg2, lg3;
        { const bool u5 = (F.lane & 32) != 0, u4 = (F.lane & 16) != 0;
          const float t0 = (u5 ? ag[2] : ag[0]) + __shfl_xor(u5 ? ag[0] : ag[2], 32), t1 = (u5 ? ag[3] : ag[1]) + __shfl_xor(u5 ? ag[1] : ag[3], 32);
          float d = (u4 ? t1 : t0) + __shfl_xor(u4 ? t0 : t1, 16);
          d += __shfl_xor(d, 8); d += __shfl_xor(d, 4); d += __shfl_xor(d, 2); d += __shfl_xor(d, 1);
          const int di = (int)__float_as_uint(d); lg0 = __uint_as_float((unsigned)__builtin_amdgcn_readlane(di, 0)); lg1 = __uint_as_float((unsigned)__builtin_amdgcn_readlane(di, 16)); lg2 = __uint_as_float((unsigned)__builtin_amdgcn_readlane(di, 32)); lg3 = __uint_as_float((unsigned)__builtin_amdgcn_readlane(di, 48)); }
        int gs = 0; float gm = lg0; if (lg1 > gm) { gm = lg1; gs = 1; } if (lg2 > gm) { gm = lg2; gs = 2; } if (lg3 > gm) { gm = lg3; gs = 3; }
        const float ptop = 1.f / (expf(lg0 - gm) + expf(lg1 - gm) + expf(lg2 - gm) + expf(lg3 - gm));
        float ae[8] = {0.f, 0.f, 0.f, 0.f, 0.f, 0.f, 0.f, 0.f};
        { const LAS f32x4* RTg = RTl + (1 + 2 * gs) * 64;
#pragma unroll
          for (int j = 0; j < 4; ++j)
#pragma unroll
              for (int i = 0; i < 4; ++i) { const f32x4 wa = RTg[((j * 4 + i) * 9) * 64], wb = RTg[((j * 4 + i) * 9 + 1) * 64]; const float hv = v[j][i];
                  ae[0] += hv * wa.x; ae[1] += hv * wa.y; ae[2] += hv * wa.z; ae[3] += hv * wa.w; ae[4] += hv * wb.x; ae[5] += hv * wb.y; ae[6] += hv * wb.z; ae[7] += hv * wb.w; } }
        float le[8];
        { const bool u5 = (F.lane & 32) != 0, u4 = (F.lane & 16) != 0, u3 = (F.lane & 8) != 0;
          float t[4], w2[2];
#pragma unroll
          for (int i = 0; i < 4; ++i) t[i] = (u5 ? ae[4 + i] : ae[i]) + __shfl_xor(u5 ? ae[i] : ae[4 + i], 32);
#pragma unroll
          for (int i = 0; i < 2; ++i) w2[i] = (u4 ? t[2 + i] : t[i]) + __shfl_xor(u4 ? t[i] : t[2 + i], 16);
          float d = (u3 ? w2[1] : w2[0]) + __shfl_xor(u3 ? w2[0] : w2[1], 8);
          d += __shfl_xor(d, 4); d += __shfl_xor(d, 2); d += __shfl_xor(d, 1);
#pragma unroll
          for (int q = 0; q < 8; ++q) le[q] = __uint_as_float((unsigned)__builtin_amdgcn_readlane((int)__float_as_uint(d), 8 * q)); }
        { int i0 = 0; float v0 = le[0];
#pragma unroll
          for (int q = 1; q < 8; ++q) if (le[q] > v0) { v0 = le[q]; i0 = q; }
          int i1 = -1; float v1 = -INFINITY;
#pragma unroll
          for (int q = 0; q < 8; ++q) if (q != i0 && le[q] > v1) { v1 = le[q]; i1 = q; }
          const float w0 = ptop / (1.f + expf(v1 - v0)), w1 = ptop - w0;
          asm volatile("" ::: "memory");
          if (F.lane == 0 && !dry) { const int e0 = gs * 8 + i0, e1 = gs * 8 + i1;
              const int lp0 = __hip_atomic_fetch_add(lcnt + e0, 1, __ATOMIC_RELAXED, __HIP_MEMORY_SCOPE_WORKGROUP), lp1 = __hip_atomic_fetch_add(lcnt + e1, 1, __ATOMIC_RELAXED, __HIP_MEMORY_SCOPE_WORKGROUP);
              const int n = __hip_atomic_fetch_add(lcnt + 64, 2, __ATOMIC_RELAXED, __HIP_MEMORY_SCOPE_WORKGROUP);
              if (n + 2 <= LN1_MAXREC) { LAS int* r0 = recs + n * 4; r0[0] = row * 2; r0[1] = e0; r0[2] = lp0; ((LAS float*)r0)[3] = w0; r0[4] = row * 2 + 1; r0[5] = e1; r0[6] = lp1; ((LAS float*)r0)[7] = w1; } } }
        asm volatile("" ::: "memory");
    } }
    }
    }
#undef LN1_LOAD
    if (!dry) {
        __syncthreads();
        if (F.tid < NE) { const int c = lcnt[F.tid]; lcnt[32 + F.tid] = c > 0 ? (int)__hip_atomic_fetch_add(cnt + F.tid * 32, (unsigned)c, RLX_AGENT) : 0; }
        __syncthreads();
        int nrec = lcnt[64]; nrec = nrec > LN1_MAXREC ? LN1_MAXREC : nrec;
        for (int n = F.tid; n < nrec; n += 512) { const LAS int* r = recs + n * 4; const int e = r[1]; const size_t idx = (size_t)e * pg8::MOE_CAP + lcnt[32 + e] + r[2];
            elist[idx] = r[0]; ewt[idx] = ((const LAS float*)r)[3]; }
    }
}
__device__ __forceinline__ void moe_tables(Frame& F, int l) {
    LAS int* offs = (LAS int*)(F.lds + MOE_TAB_OFF); LAS int* cnts = offs + 64; LAS int* tile_exp = offs + 128; LAS int* ntl = offs + 320;
    unsigned* cnt = (unsigned*)(F.ws + WS_CTL) + CW_CNT + l * 32 * 32;
    if (F.tid < NE) cnts[F.tid] = (int)__hip_atomic_load(cnt + F.tid * 32, RLX_AGENT);
    __syncthreads();
    if (F.tid == 0) { int o = 0; for (int e = 0; e < NE; ++e) { offs[e] = o; o += (cnts[e] + 255) & ~255; } offs[32] = o; ntl[0] = o >> 8; }
    __syncthreads();
    for (int t = F.tid; t < (offs[32] >> 8); t += 512) { int e = 0; while (offs[e + 1] <= t * 256) ++e; tile_exp[t] = e; }
    __syncthreads();
}
__device__ __forceinline__ void ln2_phase(Frame& F, int l, bool last, float* out, bool dry = false) {
    const float* lng = F.in[I_LNG] + (size_t)(l * 2 + 1) * D; const float* lnb = F.in[I_LNB] + (size_t)(l * 2 + 1) * D;
    const bf16* Y = (const bf16*)(F.ws + WS_Y);
    v2u xn[2][4], an[2][4], bn[2][4];
#define LN2_LOAD(b_, r_) do { const v2u* xr_ = (const v2u*)((const unsigned short*)(F.ws + WS_X) + (size_t)(r_) * D) + F.lane; \
        const v2u* y0_ = (const v2u*)(Y + (size_t)(r_) * D) + F.lane; const v2u* y1_ = (const v2u*)(Y + ((size_t)M + (r_)) * D) + F.lane; \
        _Pragma("unroll") for (int j = 0; j < 4; ++j) { xn[b_][j] = xr_[64 * j]; an[b_][j] = y0_[64 * j]; bn[b_][j] = y1_[64 * j]; } } while (0)
#pragma unroll 1
    for (int pass = last ? 1 : 0; pass < 2; ++pass) {
        const int s = 1 - pass;
        const int rfirst = pass ? NCTX + F.gw : (F.wave == 0 ? F.vcu : NCTX), rstep = pass ? F.NGW : F.G, rend = pass ? M : NCTX;
        if (rfirst >= rend) continue;
        f32x4 pg[4], plg[4], plb[4], psc[4], psh[4];
        { const f32x4* g2 = (const f32x4*)modv(F, l, s, 5) + F.lane; const int ln_ = last ? l : l + 1;
          const f32x4* sc1 = (const f32x4*)modv(F, ln_, s, 1) + F.lane; const f32x4* sh1 = (const f32x4*)modv(F, ln_, s, 0) + F.lane;
#pragma unroll
          for (int j = 0; j < 4; ++j) { pg[j] = g2[64 * j]; plg[j] = ((const f32x4*)lng)[F.lane + 64 * j]; plb[j] = ((const f32x4*)lnb)[F.lane + 64 * j]; psc[j] = sc1[64 * j] + 1.f; psh[j] = sh1[64 * j]; } }
        LN2_LOAD(0, rfirst); if (rfirst + rstep < rend) LN2_LOAD(1, rfirst + rstep);
#pragma unroll 1
        for (int row2 = rfirst; row2 < rend; row2 += 2 * rstep) {
#pragma unroll
          for (int pb = 0; pb < 2; ++pb) { const int row = row2 + pb * rstep; if (row < rend) {
            f32x4 v[4]; float sm = 0.f;
#pragma unroll
            for (int j = 0; j < 4; ++j) { const f32x4 x = {h_lo(xn[pb][j].x), h_hi(xn[pb][j].x), h_lo(xn[pb][j].y), h_hi(xn[pb][j].y)}; const v2u a = an[pb][j], b = bn[pb][j];
                const f32x4 yy = {bf_lo(a.x) + bf_lo(b.x), bf_hi(a.x) + bf_hi(b.x), bf_lo(a.y) + bf_lo(b.y), bf_hi(a.y) + bf_hi(b.y)};
                v[j] = x * DN_ALPHA + pg[j] * yy; sm += (v[j].x + v[j].y) + (v[j].z + v[j].w); }
            asm volatile("" ::: "memory");
            { const int nrow = row + 2 * rstep; if (nrow < rend) LN2_LOAD(pb, nrow); }
            asm volatile("" ::: "memory");
            const float mean = wave_sum(sm) * (1.f / D); float s2 = 0.f;
#pragma unroll
            for (int j = 0; j < 4; ++j) { v[j] = v[j] - mean; s2 += (v[j].x * v[j].x + v[j].y * v[j].y) + (v[j].z * v[j].z + v[j].w * v[j].w); }
            const float rstd = 1.0f / sqrtf(wave_sum(s2) * (1.f / D) + LN_EPS);
            if (last) {
                f32x4* xo = (f32x4*)((dry ? (float*)(F.ws + WS_QKV) : out) + (size_t)(row - NCTX) * D) + F.lane;
#pragma unroll
                for (int j = 0; j < 4; ++j) xo[64 * j] = v[j] * rstd * plg[j] + plb[j];
            } else {
                v2u* xo = (v2u*)((unsigned short*)(F.ws + (dry ? WS_QKV : WS_X)) + (size_t)row * D) + F.lane;
                v2u* ho = (v2u*)((bf16*)(F.ws + (dry ? WS_AO : WS_HB)) + (size_t)row * D) + F.lane;
#pragma unroll
                for (int j = 0; j < 4; ++j) { const f32x4 y = v[j] * rstd * plg[j] + plb[j];
                    { v2u w; w.x = pkh2(y.x, y.y); w.y = pkh2(y.z, y.w); xo[64 * j] = w; } const f32x4 h = y * psc[j] + psh[j];
                    v2u w; w.x = pk2(h.x, h.y); w.y = pk2(h.z, h.w); ho[64 * j] = w; }
            }
          } }
        }
    }
#undef LN2_LOAD
}
__device__ __forceinline__ void attn_even_phase(Frame& F, int l, int i) {
    const att::bf16* QKV = (const att::bf16*)(F.ws + WS_QKV); att::bf16* AO = (att::bf16*)(F.ws + WS_AO);
    const int wid = F.wave;
    const float lam_init = 0.8f - 0.6f * expf(-0.3f * (float)l);
    float lam;
    { const float* dl = F.in[I_DLAM] + (size_t)i * 4 * 64; const float a = wave_sum(dl[F.lane] * dl[64 + F.lane]), b = wave_sum(dl[128 + F.lane] * dl[192 + F.lane]); lam = expf(a) - expf(b) + lam_init; }
    const float* subg = F.in[I_SUBG] + (size_t)i * 128;
    const int v = F.vcu, G = F.G;
    const int chunk = (512 + G - 1) / G;
    { int tidL = F.tid; asm volatile("" : "+v"(tidL));
      for (int k = 0; k <= chunk; ++k) {
          int head, row0, NT;
          if (k < chunk) { const int u = v * chunk + k; if (u >= 512) continue; head = u >> 7; row0 = NCTX + 128 * (u & 127); NT = M / 64; }
          else { if (v >= 8) continue; head = v >> 1; row0 = 128 * (v & 1); NT = NCTX / 64; }
          att::UnitArgs a{}; const int map = wid >> 2, rw = row0 + 32 * (wid & 3);
          a.Qw = QKV + (size_t)rw * EVEN_IN + head * 128 + map * 64; a.ldq = EVEN_IN;
          a.Kh = QKV + 512 + head * 128; a.Vh = QKV + 1024 + head * 128; a.ldk = EVEN_IN; a.NT = NT; a.kcol = map * 64;
          a.Ow = AO + (size_t)rw * D + head * 128; a.ldo = D; a.lam = lam; a.subg = subg; a.oscale = 1.f - lam_init;
          att::attn_unit<128, 128, 1>(a, (char*)F.ldsg, tidL);
      } }
    { int tidL = F.tid; asm volatile("" : "+v"(tidL));
      for (int k = 0; k <= chunk; ++k) {
          int head, row0, NT;
          if (k < chunk) { const int u = v * chunk + k; if (u >= 512) continue; head = u >> 6; row0 = NCTX + 256 * (u & 63); NT = M / 64; }
          else { if (v < 8 || v >= 16) continue; head = v - 8; row0 = 0; NT = NCTX / 64; }
          const int rw = row0 + 32 * wid;
          att::UnitArgs a{};
          a.Qw = QKV + (size_t)rw * EVEN_IN + 1536 + head * 64; a.ldq = EVEN_IN;
          a.Kh = QKV + 2048 + (head >> 2) * 64; a.Vh = QKV + 2176 + (head >> 2) * 64; a.ldk = EVEN_IN; a.NT = NT; a.kcol = 0;
          a.Ow = AO + (size_t)rw * D + 512 + head * 64; a.ldo = D;
          att::attn_unit<64, 64, 0>(a, (char*)F.ldsg, tidL);
      } }
}
__device__ __forceinline__ void attn_odd_phase(Frame& F, int l, int i, bool with_ctx) {
    const att::bf16* QKV = (const att::bf16*)(F.ws + WS_QKV); att::bf16* AO = (att::bf16*)(F.ws + WS_AO);
    const int wid = F.wave, v = F.vcu, G = F.G;
    const int chunk = (1024 + G - 1) / G;
    int tidL = threadIdx.x; asm volatile("" : "+v"(tidL));
    for (int u = v * chunk; u < (v + 1) * chunk && u < 1024; ++u) {
        const int head = u >> 6, r0 = 4 * (u & 63);
        att::UnitArgs a{};
        a.na_rq = r0 + (wid >> 1); a.na_c0 = 32 * (wid & 1);
        int kr0 = r0 - 4; kr0 = kr0 < 0 ? 0 : (kr0 > 244 ? 244 : kr0); a.na_kr0 = kr0;
        const int rw = NCTX + a.na_rq * 64 + a.na_c0;
        a.Qw = QKV + (size_t)rw * ODD_IN + head * 64; a.ldq = ODD_IN;
        a.Kh = QKV + 1024 + head * 64; a.Vh = QKV + 2048 + head * 64; a.ldk = ODD_IN; a.NT = 16; a.kcol = 0;
        a.Ow = AO + (size_t)rw * D + head * 64; a.ldo = D;
        a.rpb = F.in[I_RPB] + ((size_t)i * 16 + head) * 15 * 31;
        att::attn_unit<64, 64, 2>(a, (char*)F.ldsg, tidL);
    }
    if (with_ctx && v < 16) { const int head = v, rw = 32 * wid;
        att::UnitArgs a{};
        a.Qw = QKV + (size_t)rw * ODD_IN + head * 64; a.ldq = ODD_IN;
        a.Kh = QKV + 1024 + head * 64; a.Vh = QKV + 2048 + head * 64; a.ldk = ODD_IN; a.NT = NCTX / 64; a.kcol = 0;
        a.Ow = AO + (size_t)rw * D + head * 64; a.ldo = D;
        int tidM = threadIdx.x; asm volatile("" : "+v"(tidM));
        att::attn_unit<64, 64, 0>(a, (char*)F.ldsg, tidM); }
}

constexpr int PH_PER_LAYER = 9, N_PHASES = 2 + DEPTH * PH_PER_LAYER;
__global__ void __launch_bounds__(NWAVES * 64, 2) fwd_kernel(Args args) {
    extern __shared__ __attribute__((aligned(16))) unsigned char lds[];
    Frame F;
#define PHASE_FRAME() do { int t_ = threadIdx.x; asm volatile("" : "+v"(t_)); const int z_ = launder_i(0); const int bx_ = (int)blockIdx.x + z_; \
    F.lds = (LAS unsigned char*)lds; F.ldsg = lds; F.ws = args.ws + z_; F.in = args.in + z_; F.bx = bx_; \
    F.tid = t_; F.lane = t_ & 63; F.wave = __builtin_amdgcn_readfirstlane(t_ >> 6); \
    F.G = gridDim.x; F.vcu = (F.G % 8 == 0) ? (bx_ % 8) * (F.G / 8) + bx_ / 8 : bx_; \
    F.gw = F.vcu * NWAVES + F.wave; F.NGW = F.G * NWAVES; } while (0)
    PHASE_FRAME();
    volatile LAS unsigned* MISC = (volatile LAS unsigned*)(F.lds + MISC_OFF);
    if (F.tid < 64) MISC[F.tid] = 0u;
    __syncthreads();
    unsigned* ctl = (unsigned*)(args.ws + WS_CTL);
    XcdBarrier bar; bar.bar = ctl + CW_BAR; bar.x = 0; bar.st = nullptr;
    const int lo = args.ph_lo, hi = args.ph_hi;
    if (hi - lo > 1) bar = xcd_barrier_post(ctl + CW_BAR, MISC + 8);
#ifndef DBG_MASK
#define DBG_MASK 0xffff
#endif
#ifndef DBG_REP
#define DBG_REP 0
#endif
#define NREP(bit) ((DBG_REP & (bit)) ? 2 : 1)
#define IN(k) (lo <= (k) && (k) < hi)
#define SEAM(k) do { if (IN(k) && IN((k) + 1)) xcd_barrier(bar); } while (0)
    if ((DBG_MASK & 1) && IN(0)) for (int rep_ = 0; rep_ < NREP(1); ++rep_) { PHASE_FRAME(); p0a(F); __syncthreads(); }
    SEAM(0);
    if ((DBG_MASK & 2) && IN(1)) { PHASE_FRAME(); p0b(F); }
    SEAM(1);
    for (int lp = 0; lp < 2; ++lp) {
        { const int l = 2 * lp, i = lp, pb = 2 + l * PH_PER_LAYER;
          if ((DBG_MASK & 4) && IN(pb + 0)) for (int rep_ = 0; rep_ < NREP(4); ++rep_) { PHASE_FRAME(); pg8::Gemm g{(const bf16*)(F.ws + WS_HB), (const bf16*)(F.ws + WS_WINE) + (size_t)i * EVEN_IN * D, M, EVEN_IN, D};
              pg8::StaticOrder S0; S0.init(M, EVEN_IN, F.G, F.bx); pg8::PreOrder S; S.init(S0); pg8::EpiBf16S E{(bf16*)(F.ws + WS_QKV), EVEN_IN, 0, 1.f};
              pg8::gemm_phase<pg8::EpiBf16S, pg8::PreOrder, 1024, true, false>(F.lds, g, S, E, F.tid); }
          SEAM(pb + 0);
          if ((DBG_MASK & 8) && IN(pb + 1)) { PHASE_FRAME(); if (DBG_REP & 8) qkpost(F, i, true); qkpost(F, i); }
          SEAM(pb + 1);
          if ((DBG_MASK & 16) && IN(pb + 2)) for (int rep_ = 0; rep_ < NREP(16); ++rep_) { PHASE_FRAME(); attn_even_phase(F, l, i); }
          SEAM(pb + 2);
          if ((DBG_MASK & 4) && IN(pb + 3)) for (int rep_ = 0; rep_ < NREP(2048); ++rep_) { PHASE_FRAME(); pg8::Gemm g{(const bf16*)(F.ws + WS_AO), (const bf16*)(F.ws + WS_WOUTE) + (size_t)i * D * D, M, D, D};
              pg8::StaticOrder S0; S0.init(M, D, F.G, F.bx); pg8::PreOrder S; S.init(S0); pg8::EpiBf16S E{(bf16*)(F.ws + WS_MIX), D, 0, 1.f};
              pg8::gemm_phase<pg8::EpiBf16S, pg8::PreOrder, 1024, true, false>(F.lds, g, S, E, F.tid); }
          SEAM(pb + 3);
          if ((DBG_MASK & 64) && IN(pb + 4)) { PHASE_FRAME(); if (DBG_REP & 64) { ln1_phase(F, l, false, true); __syncthreads(); } ln1_phase(F, l, false); __syncthreads(); }
          SEAM(pb + 4);
          if ((DBG_MASK & 256) && IN(pb + 6)) for (int rep_ = 0; rep_ < NREP(256); ++rep_) { PHASE_FRAME(); moe_tables(F, l); const LAS int* mt_ = (const LAS int*)(F.lds + MOE_TAB_OFF);
              pg8::Gemm g{(const bf16*)(F.ws + WS_HB), (const bf16*)(F.ws + WS_W13) + (size_t)l * NE * 1024 * D, AS_ROWS, 1024, D};
              pg8::MoeOrder S{mt_, mt_ + 64, mt_ + 128, mt_[320], F.G, F.bx, (const int*)(F.ws + WS_ELIST), D}; pg8::EpiSwiglu E{(bf16*)(F.ws + WS_HMID)};
              pg8::gemm_phase<pg8::EpiSwiglu, pg8::MoeOrder, 1024, true, true>(F.lds, g, S, E, F.tid); }
          SEAM(pb + 6);
          if ((DBG_MASK & 512) && IN(pb + 7)) for (int rep_ = 0; rep_ < NREP(512); ++rep_) { PHASE_FRAME(); if (!IN(pb + 6)) moe_tables(F, l);     const LAS int* mt_ = (const LAS int*)(F.lds + MOE_TAB_OFF);
              pg8::Gemm g{(const bf16*)(F.ws + WS_HMID), (const bf16*)(F.ws + WS_W2) + (size_t)l * NE * D * DE, AS_ROWS, D, DE};
              pg8::MoeOrder S{mt_, mt_ + 64, mt_ + 128, mt_[320], F.G, F.bx, (const int*)(F.ws + WS_ELIST), DE};
              pg8::EpiMoeOut E{mt_, mt_ + 64, (const int*)(F.ws + WS_ELIST), (const float*)(F.ws + WS_EWT), (bf16*)(F.ws + WS_Y)};
              pg8::gemm_phase<pg8::EpiMoeOut, pg8::MoeOrder, 512, true, false>(F.lds, g, S, E, F.tid); }
          SEAM(pb + 7);
          if ((DBG_MASK & 1024) && IN(pb + 8)) { PHASE_FRAME(); if (DBG_REP & 1024) ln2_phase(F, l, false, args.out, true); ln2_phase(F, l, false, args.out); }
          SEAM(pb + 8);
        }
        { const int l = 2 * lp + 1, i = lp, pb = 2 + l * PH_PER_LAYER; const bool last = (l == DEPTH - 1);
          if ((DBG_MASK & 4) && IN(pb + 0)) for (int rep_ = 0; rep_ < NREP(4); ++rep_) { PHASE_FRAME(); pg8::Gemm g{(const bf16*)(F.ws + WS_HB), (const bf16*)(F.ws + WS_WINO) + (size_t)i * ODD_IN * D, M, ODD_IN, D};
              pg8::StaticOrder S0; S0.init(M, ODD_IN, F.G, F.bx); pg8::PreOrder S; S.init(S0); pg8::EpiBf16S E{(bf16*)(F.ws + WS_QKV), ODD_IN, 1024, C2};
              pg8::gemm_phase<pg8::EpiBf16S, pg8::PreOrder, 1024, true, false>(F.lds, g, S, E, F.tid); }
          SEAM(pb + 0);
          SEAM(pb + 1);
          if ((DBG_MASK & 32) && IN(pb + 2)) for (int rep_ = 0; rep_ < NREP(32); ++rep_) { PHASE_FRAME(); attn_odd_phase(F, l, i, !last); }
          SEAM(pb + 2);
          if ((DBG_MASK & 4) && IN(pb + 3)) for (int rep_ = 0; rep_ < NREP(2048); ++rep_) { PHASE_FRAME(); pg8::Gemm g{(const bf16*)(F.ws + WS_AO), (const bf16*)(F.ws + WS_WOUTO) + (size_t)i * D * D, M, D, D};
              pg8::StaticOrder S0; S0.init(M, D, F.G, F.bx); pg8::PreOrder S; S.init(S0); pg8::EpiBf16S E{(bf16*)(F.ws + WS_MIX), D, 0, 1.f};
              pg8::gemm_phase<pg8::EpiBf16S, pg8::PreOrder, 1024, true, false>(F.lds, g, S, E, F.tid); }
          SEAM(pb + 3);
          if ((DBG_MASK & 64) && IN(pb + 4)) { PHASE_FRAME(); if (DBG_REP & 64) { ln1_phase(F, l, last, true); __syncthreads(); } ln1_phase(F, l, last); __syncthreads(); }
          SEAM(pb + 4);
          if ((DBG_MASK & 256) && IN(pb + 6)) for (int rep_ = 0; rep_ < NREP(256); ++rep_) { PHASE_FRAME(); moe_tables(F, l); const LAS int* mt_ = (const LAS int*)(F.lds + MOE_TAB_OFF);
              pg8::Gemm g{(const bf16*)(F.ws + WS_HB), (const bf16*)(F.ws + WS_W13) + (size_t)l * NE * 1024 * D, AS_ROWS, 1024, D};
              pg8::MoeOrder S{mt_, mt_ + 64, mt_ + 128, mt_[320], F.G, F.bx, (const int*)(F.ws + WS_ELIST), D}; pg8::EpiSwiglu E{(bf16*)(F.ws + WS_HMID)};
              pg8::gemm_phase<pg8::EpiSwiglu, pg8::MoeOrder, 1024, true, true>(F.lds, g, S, E, F.tid); }
          SEAM(pb + 6);
          if ((DBG_MASK & 512) && IN(pb + 7)) for (int rep_ = 0; rep_ < NREP(512); ++rep_) { PHASE_FRAME(); if (!IN(pb + 6)) moe_tables(F, l);     const LAS int* mt_ = (const LAS int*)(F.lds + MOE_TAB_OFF);
              pg8::Gemm g{(const bf16*)(F.ws + WS_HMID), (const bf16*)(F.ws + WS_W2) + (size_t)l * NE * D * DE, AS_ROWS, D, DE};
              pg8::MoeOrder S{mt_, mt_ + 64, mt_ + 128, mt_[320], F.G, F.bx, (const int*)(F.ws + WS_ELIST), DE};
              pg8::EpiMoeOut E{mt_, mt_ + 64, (const int*)(F.ws + WS_ELIST), (const float*)(F.ws + WS_EWT), (bf16*)(F.ws + WS_Y)};
              pg8::gemm_phase<pg8::EpiMoeOut, pg8::MoeOrder, 512, true, false>(F.lds, g, S, E, F.tid); }
          SEAM(pb + 7);
          if ((DBG_MASK & 1024) && IN(pb + 8)) { PHASE_FRAME(); if (DBG_REP & 1024) ln2_phase(F, l, last, args.out, true); ln2_phase(F, l, last, args.out); }
          SEAM(pb + 8);
        }
    }
#undef IN
#undef SEAM
}

extern "C" void kernel_launch(void* const* d_in, const int* in_sizes, int n_in, void* d_out, int out_size, void* d_ws, size_t ws_size, hipStream_t stream) {
    static int grid = 0;
    if (grid == 0) {
        if (n_in != 21 || out_size != SEQ * D || ws_size < WS_END) { fprintf(stderr, "kernel_launch: unexpected shapes (n_in %d out %d ws %zu)\n", n_in, out_size, ws_size); grid = -1; return; }
        int dev = 0, cus = 0, per_cu = 0;
        if (hipGetDevice(&dev) != hipSuccess || hipDeviceGetAttribute(&cus, hipDeviceAttributeMultiprocessorCount, dev) != hipSuccess) { grid = -1; return; }
        if (hipFuncSetAttribute((const void*)fwd_kernel, hipFuncAttributeMaxDynamicSharedMemorySize, LDS_BYTES) != hipSuccess) { fprintf(stderr, "kernel_launch: hipFuncSetAttribute failed\n"); grid = -1; return; }
        if (hipOccupancyMaxActiveBlocksPerMultiprocessor(&per_cu, (const void*)fwd_kernel, NWAVES * 64, LDS_BYTES) != hipSuccess || per_cu < 1)
            fprintf(stderr, "kernel_launch: occupancy query reports %d blocks per CU\n", per_cu);
        (void)hipGetLastError();
        grid = cus;
    }
    if (grid < 0) return;
    (void)hipMemsetAsync((char*)d_ws + WS_CTL, 0, CTL_ZERO_BYTES, stream);
    Args a{};
    for (int i = 0; i < 21; ++i) a.in[i] = (const float*)d_in[i];
    a.out = (float*)d_out; a.ws = (unsigned char*)d_ws;
#if MK_ONE_LAUNCH
    a.ph_lo = 0; a.ph_hi = N_PHASES;
    hipLaunchKernelGGL(fwd_kernel, dim3(grid), dim3(NWAVES * 64), LDS_BYTES, stream, a);
#else
#ifndef DBG_MAXPH
#define DBG_MAXPH N_PHASES
#endif
    for (int p = 0; p < DBG_MAXPH; ++p) {
        if (p >= 2 && ((p - 2) / PH_PER_LAYER) % 2 == 1 && (p - 2) % PH_PER_LAYER == 1) continue;
        a.ph_lo = p; a.ph_hi = p + 1;
        hipLaunchKernelGGL(fwd_kernel, dim3(grid), dim3(NWAVES * 64), LDS_BYTES, stream, a);
    }
#endif
    const hipError_t le = hipPeekAtLastError();
    if (le != hipSuccess) fprintf(stderr, "kernel_launch: launch failed: %s\n", hipGetErrorName(le));
}
```

```cpp
#include <hip/hip_runtime.h>
#include <hip/hip_bf16.h>
#include <cstdio>
#include <cstdint>

#ifndef MK_ONE_LAUNCH
#define MK_ONE_LAUNCH 1
#endif

constexpr int D = 1024, SEQ = 16384, NCTX = 256, M = SEQ + NCTX, DEPTH = 4;
constexpr int EVEN_IN = 2304, ODD_IN = 3072;
constexpr int NE = 32, DE = 512;
constexpr int AS_TILES = 162, AS_ROWS = AS_TILES * 256;
constexpr float DN_ALPHA = 1.6817928305074290f;
constexpr float LOG2E = 1.4426950408889634f;
constexpr float C2 = 0.125f * LOG2E;
constexpr float LN_EPS = 1e-6f;

namespace pg8 {
#define PG8_LAS __attribute__((address_space(3)))
typedef unsigned short bf16_t;
typedef short bf16x8 __attribute__((ext_vector_type(8)));
typedef float f32x4 __attribute__((ext_vector_type(4)));
typedef unsigned u32x4 __attribute__((ext_vector_type(4)));
constexpr int BM = 256, BK = 64, HALF = 128, HTB = HALF * BK * 2, STAGE_BYTES = 8 * HTB, NXCD = 8, WGM = 8;

__host__ __device__ __forceinline__ int lds_byte(int r, int c) { const int st = (r >> 4) * 2 + (c >> 5), rr = r & 15, cc = c & 31, ob = rr * 64 + cc * 2; return st * 1024 + (ob ^ (((ob >> 9) & 1) << 5)); }
__host__ __device__ __forceinline__ void stage_rc(int b, int& R, int& C) { const int st = b / 1024, sb = b % 1024, swz = sb ^ (((sb >> 9) & 1) << 5); R = (st >> 1) * 16 + swz / 64; C = (st & 1) * 32 + (swz % 64) / 2; }
__host__ __device__ __forceinline__ int perm32(int rho) { const int n = rho >> 4, i = rho & 15; return 8 * (i >> 2) + 4 * n + (i & 3); }

struct Unit { int pm, pn, hs; };
struct Gemm { const bf16_t* A; const bf16_t* Bt; int M, N, K; };

struct StaticOrder {
    int nM, nN, nwg, G, c;
    __host__ __device__ void init(int M_, int N_, int G_, int c_) { nM = M_ / BM; nN = N_ / BM; nwg = nM * nN; G = G_; c = c_; }
    __host__ __device__ bool next(int i, Unit& u) const {
        const int R = nwg / G, left = nwg - R * G; long L = (long)i * G + c; u.hs = 0;
        if (left > 0 && 2 * left <= G && i == R) { if (c >= 2 * left) return false; L = (long)R * G + (c >> 1); u.hs = 1 + (c & 1); }
        if (L >= nwg) return false;
        int wgid = (int)L; { const int q = nwg / NXCD, r = nwg % NXCD, xcd = wgid % NXCD, off = wgid / NXCD; wgid = (xcd < r ? xcd * (q + 1) : r * (q + 1) + (xcd - r) * q) + off; }
        const int nig = WGM * nN, gid = wgid / nig, fm = gid * WGM, gsz = (nM - fm) < WGM ? (nM - fm) : WGM;
        u.pm = fm + ((wgid % nig) % gsz); u.pn = (wgid % nig) / gsz; return true;
    }
    __device__ __forceinline__ void a_ready(const Unit&) const {}
    __device__ __forceinline__ void done(const Unit&) const {}
};
struct PreOrder {
    int n; unsigned lo, hi;
    __device__ __forceinline__ void init(const StaticOrder& S) { Unit u; int nn = 0; unsigned l = 0u, h = 0u;
        if (S.next(0, u)) { l = (unsigned)u.pm | ((unsigned)u.pn << 8) | ((unsigned)u.hs << 12); nn = 1;
            if (S.next(1, u)) { l |= ((unsigned)u.pm | ((unsigned)u.pn << 8) | ((unsigned)u.hs << 12)) << 16; nn = 2;
                if (S.next(2, u)) { h = (unsigned)u.pm | ((unsigned)u.pn << 8) | ((unsigned)u.hs << 12); nn = 3;
                    if (S.next(3, u)) { h |= ((unsigned)u.pm | ((unsigned)u.pn << 8) | ((unsigned)u.hs << 12)) << 16; nn = 4; } } } }
        n = __builtin_amdgcn_readfirstlane(nn); lo = (unsigned)__builtin_amdgcn_readfirstlane((int)l); hi = (unsigned)__builtin_amdgcn_readfirstlane((int)h); }
    __device__ __forceinline__ unsigned aoff(const Unit&, int, int, int) const { return 0u; }
    __device__ __forceinline__ bool next(int i, Unit& u) const { if (i >= n) return false; const unsigned w = ((i & 2) ? hi : lo) >> ((i & 1) * 16); u.pm = (int)(w & 0xffu); u.pn = (int)((w >> 8) & 0xfu); u.hs = (int)((w >> 12) & 3u); return true; }
    __device__ __forceinline__ void a_ready(const Unit&) const {}
    __device__ __forceinline__ void done(const Unit&) const {}
};
constexpr int MOE_CAP = 16640;
struct MoeOrder {
    const PG8_LAS int* offs; const PG8_LAS int* cnts; const PG8_LAS int* tile_exp; int n_tiles, G, c;
    const int* elist; int lda;
    __device__ bool next(int i, Unit& u) const {
        const int nwg = n_tiles * 4; const int R = nwg / G, left = nwg - R * G; long L = (long)i * G + c; u.hs = 0;
        if (left > 0 && 2 * left <= G && i == R) { if (c >= 2 * left) return false; L = (long)R * G + (c >> 1); u.hs = 1 + (c & 1); }
        if (L >= nwg) return false;
        int wgid = (int)L; { const int q = nwg / NXCD, r = nwg % NXCD, xcd = wgid % NXCD, off = wgid / NXCD; wgid = (xcd < r ? xcd * (q + 1) : r * (q + 1) + (xcd - r) * q) + off; }
        const int mt = wgid >> 2; const int e = __builtin_amdgcn_readfirstlane(tile_exp[mt]);
        u.pm = mt; u.pn = e * 4 + (wgid & 3); return true;
    }
    __device__ __forceinline__ int aent(const Unit& u, int h, int R) const { const int e = u.pn >> 2, pos = u.pm * BM + (u.hs ? u.hs - 1 : h) * HALF + R - offs[e]; return elist[(size_t)e * MOE_CAP + pos]; }
    __device__ __forceinline__ unsigned afin(const Unit& u, int h, int R, int C, int ent) const {
        const int e = u.pn >> 2, pos = u.pm * BM + (u.hs ? u.hs - 1 : h) * HALF + R - offs[e];
        const int tok = (pos < cnts[e]) ? (ent >> 1) : 0;
        return (unsigned)(tok * lda + C) * 2u;
    }
    __device__ __forceinline__ unsigned aoff(const Unit& u, int h, int R, int C) const { return afin(u, h, R, C, aent(u, h, R)); }
    __device__ __forceinline__ void a_ready(const Unit&) const {}
    __device__ __forceinline__ void done(const Unit&) const {}
};

__device__ __forceinline__ unsigned cvt_pk_bf16(float lo, float hi) { unsigned r; asm volatile("v_cvt_pk_bf16_f32 %0, %1, %2" : "=v"(r) : "v"(lo), "v"(hi)); return r; }

struct EpiBf16S {
    static constexpr bool PERM = true, AFTER_DRAIN = false;
    bf16_t* O; int ldc; int scale_cols; float scale0;
    __device__ __forceinline__ void operator()(const f32x4 (&acc)[2][2][4][2], const Unit& u, int wr, int wc, int fr, int fq) const {
        const int row0 = u.pm * BM + (u.hs == 2 ? HALF : 0) + wr * 64 + fr; const int colt = u.pn * BM;
        const float sc = (colt < scale_cols) ? scale0 : 1.f;
        const int col0 = colt + wc * 32 + 8 * fq;
#pragma unroll
        for (int ai = 0; ai < 2; ++ai) if (ai == 0 || !u.hs)
#pragma unroll
            for (int m = 0; m < 4; ++m) { bf16_t* rowp = O + (size_t)(row0 + ai * HALF + m * 16) * ldc + col0;
#pragma unroll
                for (int bj = 0; bj < 2; ++bj) { f32x4 v0 = acc[ai][bj][m][0] * sc, v1 = acc[ai][bj][m][1] * sc;
                    u32x4 w; w.x = cvt_pk_bf16(v0[0], v0[1]); w.y = cvt_pk_bf16(v0[2], v0[3]); w.z = cvt_pk_bf16(v1[0], v1[1]); w.w = cvt_pk_bf16(v1[2], v1[3]);
                    *(u32x4*)(rowp + bj * HALF) = w; } }
    }
};
__device__ __forceinline__ float silu_f(float a) { return a * __builtin_amdgcn_rcpf(1.f + __builtin_amdgcn_exp2f(-a * 1.4426950408889634f)); }
struct EpiSwiglu {
    static constexpr bool PERM = true, AFTER_DRAIN = false;
    bf16_t* H;
    __device__ __forceinline__ void operator()(const f32x4 (&acc)[2][2][4][2], const Unit& u, int wr, int wc, int fr, int fq) const {
        const int row0 = u.pm * BM + (u.hs == 2 ? HALF : 0) + wr * 64 + fr; const int col0 = (u.pn & 3) * 128 + wc * 32 + 8 * fq;
#pragma unroll
        for (int ai = 0; ai < 2; ++ai) if (ai == 0 || !u.hs)
#pragma unroll
            for (int m = 0; m < 4; ++m) { bf16_t* rowp = H + (size_t)(row0 + ai * HALF + m * 16) * DE + col0;
                const f32x4 a0 = acc[ai][0][m][0], a1 = acc[ai][0][m][1], b0 = acc[ai][1][m][0], b1 = acc[ai][1][m][1];
                float h[8];
#pragma unroll
                for (int i = 0; i < 4; ++i) { h[i] = silu_f(a0[i]) * b0[i]; h[4 + i] = silu_f(a1[i]) * b1[i]; }
                u32x4 w; w.x = cvt_pk_bf16(h[0], h[1]); w.y = cvt_pk_bf16(h[2], h[3]); w.z = cvt_pk_bf16(h[4], h[5]); w.w = cvt_pk_bf16(h[6], h[7]);
                *(u32x4*)rowp = w; }
    }
};
struct EpiMoeOut {
    static constexpr bool PERM = true, AFTER_DRAIN = false;
    const PG8_LAS int* offs; const PG8_LAS int* cnts; const int* elist; const float* ewt; bf16_t* Y;
    __device__ __forceinline__ void operator()(const f32x4 (&acc)[2][2][4][2], const Unit& u, int wr, int wc, int fr, int fq) const {
        const int col0 = (u.pn & 3) * BM + wc * 32 + 8 * fq; const int e = u.pn >> 2; const int o0 = offs[e], cn = cnts[e];
        int tsv[2][4]; float wv[2][4];
#pragma unroll
        for (int ai = 0; ai < 2; ++ai)
#pragma unroll
            for (int m = 0; m < 4; ++m) { const int pos = u.pm * BM + (u.hs == 2 ? HALF : 0) + ai * HALF + wr * 64 + m * 16 + fr - o0; const int pc = pos < MOE_CAP ? pos : 0;
                tsv[ai][m] = elist[(size_t)e * MOE_CAP + pc]; wv[ai][m] = ewt[(size_t)e * MOE_CAP + pc]; }
#pragma unroll
        for (int ai = 0; ai < 2; ++ai) if (ai == 0 || !u.hs)
#pragma unroll
            for (int m = 0; m < 4; ++m) { const int pos = u.pm * BM + (u.hs == 2 ? HALF : 0) + ai * HALF + wr * 64 + m * 16 + fr - o0;
                if (pos < cn) { const int ts = tsv[ai][m]; const float w = wv[ai][m]; bf16_t* rowp = Y + ((size_t)(ts & 1) * M + (size_t)(ts >> 1)) * D + col0;
#pragma unroll
                    for (int bj = 0; bj < 2; ++bj) { f32x4 v0 = acc[ai][bj][m][0] * w, v1 = acc[ai][bj][m][1] * w;
                        u32x4 o; o.x = cvt_pk_bf16(v0[0], v0[1]); o.y = cvt_pk_bf16(v0[2], v0[3]); o.z = cvt_pk_bf16(v1[0], v1[1]); o.w = cvt_pk_bf16(v1[2], v1[3]);
                        *(u32x4*)(rowp + bj * HALF) = o; } } }
    }
};

template <class Epi, class Sched, int KK, bool ALIGN_EPI = false, bool GATHER = false>
__device__ __forceinline__ void gemm_phase(PG8_LAS unsigned char* lds, const Gemm g, const Sched& S, const Epi& E, const int tid) {
    const int wid = __builtin_amdgcn_readfirstlane(tid >> 6), lane = tid & 63, wr = wid >> 2, wc = wid & 3, fr = lane & 15, fq = lane >> 4;
    constexpr int K = KK, nt = K / BK;
    unsigned voffA[2], voffB[2]; int gR[2], gC[2];
#pragma unroll
    for (int i = 0; i < 2; ++i) { int R, C; stage_rc(tid * 16 + i * 8192, R, C); const int Rb = Epi::PERM ? ((R & ~31) + perm32(R & 31)) : R; gR[i] = R; gC[i] = C;
        voffA[i] = (unsigned)(R * K + C) * 2u; voffB[i] = (unsigned)(Rb * K + C) * 2u; }
    unsigned gcur[2][2] = {{0u, 0u}, {0u, 0u}}, gnxt[2][2] = {{0u, 0u}, {0u, 0u}};
    const size_t kstep = (size_t)(BK * 2);
    const size_t hstep = (size_t)HALF * K * 2;
    const size_t tstep = 2 * hstep;
    const unsigned ldsw = (unsigned)wid * 1024u;
    const int aoff = lds_byte(wr * 64 + fr, fq * 8), boff = lds_byte(wc * 32 + fr, fq * 8);
#define PG8_SA(b, h) (((b) * 2 + (h)) * HTB)
#define PG8_SB(b, h) ((4 + (b) * 2 + (h)) * HTB)
#define PG8_STAGE(bufoff, gbase, voff) do { _Pragma("unroll") for (int _i = 0; _i < 2; ++_i) \
        __builtin_amdgcn_global_load_lds((const unsigned*)((const char*)(gbase) + (voff)[_i]), (PG8_LAS unsigned*)(lds + (bufoff) + ldsw + _i * 8192), 16, 0, 0); } while (0)
#define PG8_STAGE_A(bufoff, gbase, h, goffs, hm) do { if constexpr (GATHER) { PG8_STAGE(bufoff, gbase, (goffs)[h]); } else { PG8_STAGE(bufoff, (gbase) + (h) * (hm), voffA); } } while (0)
#define PG8_GOFF(dst, u) do { int ent_[2][2]; _Pragma("unroll") for (int _h = 0; _h < 2; ++_h) _Pragma("unroll") for (int _i = 0; _i < 2; ++_i) ent_[_h][_i] = S.aent(u, _h, gR[_i]); \
        _Pragma("unroll") for (int _h = 0; _h < 2; ++_h) _Pragma("unroll") for (int _i = 0; _i < 2; ++_i) dst[_h][_i] = S.afin(u, _h, gR[_i], gC[_i], ent_[_h][_i]); } while (0)
#define PG8_LDA(dst, b, h) do { _Pragma("unroll") for (int m = 0; m < 4; ++m) _Pragma("unroll") for (int k = 0; k < 2; ++k) dst[m][k] = *(const PG8_LAS bf16x8*)(lds + PG8_SA(b, h) + aoff + m * 2048 + k * 1024); } while (0)
#define PG8_LDB(dst, b, h) do { _Pragma("unroll") for (int n = 0; n < 2; ++n) _Pragma("unroll") for (int k = 0; k < 2; ++k) dst[n][k] = *(const PG8_LAS bf16x8*)(lds + PG8_SB(b, h) + boff + n * 2048 + k * 1024); } while (0)
#define PG8_MMA(ai, bj, At, Bt) do { __builtin_amdgcn_s_setprio(1); _Pragma("unroll") for (int m = 0; m < 4; ++m) _Pragma("unroll") for (int n = 0; n < 2; ++n) _Pragma("unroll") for (int k = 0; k < 2; ++k) \
        acc[ai][bj][m][n] = __builtin_amdgcn_mfma_f32_16x16x32_bf16(Bt[n][k], At[m][k], acc[ai][bj][m][n], 0, 0, 0); __builtin_amdgcn_s_setprio(0); } while (0)
#define PG8_WAIT_V(n) asm volatile("s_waitcnt vmcnt(" #n ")" ::: "memory")
#define PG8_WAIT_VH(f) do { if (f) { PG8_WAIT_V(8); } else { PG8_WAIT_V(6); } } while (0)
#define PG8_WAIT_L(n) asm volatile("s_waitcnt lgkmcnt(" #n ")" ::: "memory")
#define PG8_BAR __builtin_amdgcn_s_barrier()
#define PG8_SCHED __builtin_amdgcn_sched_barrier(0)
    Unit cur, nxt; int ui = 0;
    if (!S.next(0, cur)) return;
    f32x4 acc[2][2][4][2];
#pragma unroll
    for (int a = 0; a < 2; ++a)
#pragma unroll
        for (int b = 0; b < 2; ++b)
#pragma unroll
            for (int m = 0; m < 4; ++m)
#pragma unroll
                for (int n = 0; n < 2; ++n) acc[a][b][m][n] = (f32x4){0.f, 0.f, 0.f, 0.f};
    bf16x8 At[4][2], B0[2][2], B1[2][2];
    const char* cA = GATHER ? (const char*)g.A : (const char*)g.A + (size_t)cur.pm * tstep + (cur.hs == 2 ? hstep : (size_t)0); size_t chm = cur.hs ? (size_t)0 : hstep, nhm = chm; const char* cB = (const char*)g.Bt + (size_t)cur.pn * tstep;
    if constexpr (GATHER) { PG8_GOFF(gcur, cur); }
    S.a_ready(cur);
    {
        PG8_STAGE(PG8_SB(0, 0), cB, voffB); PG8_STAGE(PG8_SB(0, 1), cB + hstep, voffB); PG8_STAGE_A(PG8_SA(0, 0), cA, 0, gcur, chm); PG8_STAGE_A(PG8_SA(0, 1), cA, 1, gcur, chm);
        if (wr == 1) PG8_BAR;
        PG8_WAIT_V(2); PG8_BAR;
        PG8_STAGE(PG8_SB(1, 0), cB + kstep, voffB); PG8_STAGE_A(PG8_SA(1, 0), cA + kstep, 0, gcur, chm); PG8_STAGE(PG8_SB(1, 1), cB + hstep + kstep, voffB);
        PG8_WAIT_V(6); PG8_BAR;
    }
    for (;;) {
        const bool has_next = S.next(ui + 1, nxt);
        const char* nA = GATHER ? cA : (has_next ? (const char*)g.A + (size_t)nxt.pm * tstep + (nxt.hs == 2 ? hstep : (size_t)0) : cA); nhm = has_next ? (nxt.hs ? (size_t)0 : hstep) : chm; const bool full = (cur.hs == 0); const char* nB = has_next ? (const char*)g.Bt + (size_t)nxt.pn * tstep : cB;
        if constexpr (GATHER) { if (has_next) { PG8_GOFF(gnxt, nxt); } else {
#pragma unroll
            for (int h = 0; h < 2; ++h) { gnxt[h][0] = gcur[h][0]; gnxt[h][1] = gcur[h][1]; } } }
        for (int t = 0; t < nt; t += 2) {
            const bool last = (t == nt - 2);
            const char* a1 = cA + (size_t)(t + 1) * kstep;
            const char* a2 = last ? nA : cA + (size_t)(t + 2) * kstep; const char* b2 = last ? nB : cB + (size_t)(t + 2) * kstep;
            const char* a3 = a2 + kstep; const char* b3 = b2 + kstep;
            unsigned s2[2][2];
#pragma unroll
            for (int h = 0; h < 2; ++h) { s2[h][0] = last ? gnxt[h][0] : gcur[h][0]; s2[h][1] = last ? gnxt[h][1] : gcur[h][1]; }
            const size_t hm2 = last ? nhm : chm; const bool f2 = (hm2 != 0);
            if (last && has_next) S.a_ready(nxt);
            PG8_LDB(B0, 0, 0); PG8_LDB(B1, 0, 1); PG8_SCHED; PG8_LDA(At, 0, 0); if (full) { PG8_STAGE_A(PG8_SA(1, 1), a1, 1, gcur, chm); }
            PG8_WAIT_VH(full); PG8_WAIT_L(0); PG8_BAR; PG8_MMA(0, 0, At, B0); PG8_MMA(0, 1, At, B1); PG8_BAR; PG8_SCHED;
            if (full) { PG8_LDA(At, 0, 1); } PG8_STAGE(PG8_SB(0, 0), b2, voffB); PG8_STAGE(PG8_SB(0, 1), b2 + hstep, voffB); PG8_STAGE_A(PG8_SA(0, 0), a2, 0, s2, hm2);
            PG8_WAIT_VH(full); PG8_WAIT_L(0); PG8_BAR; if (full) { PG8_MMA(1, 0, At, B0); PG8_MMA(1, 1, At, B1); } PG8_BAR; PG8_SCHED;
            PG8_LDB(B0, 1, 0); PG8_LDB(B1, 1, 1); PG8_SCHED; PG8_LDA(At, 1, 0); if (f2) { PG8_STAGE_A(PG8_SA(0, 1), a2, 1, s2, hm2); }
            PG8_WAIT_VH(f2); PG8_WAIT_L(0); PG8_BAR; PG8_MMA(0, 0, At, B0); PG8_MMA(0, 1, At, B1); PG8_BAR; PG8_SCHED;
            if (full) { PG8_LDA(At, 1, 1); } PG8_STAGE(PG8_SB(1, 0), b3, voffB); PG8_STAGE(PG8_SB(1, 1), b3 + hstep, voffB); PG8_STAGE_A(PG8_SA(1, 0), a3, 0, s2, hm2);
            PG8_WAIT_VH(f2); PG8_WAIT_L(0); PG8_BAR; if (full) { PG8_MMA(1, 0, At, B0); PG8_MMA(1, 1, At, B1); } PG8_BAR; PG8_SCHED;
        }
        if constexpr (ALIGN_EPI) { if (wr == 0) PG8_BAR; }
        if constexpr (!Epi::AFTER_DRAIN) { E(acc, cur, wr, wc, fr, fq); S.done(cur); }
        if (!has_next) break;
#pragma unroll
        for (int a = 0; a < 2; ++a)
#pragma unroll
            for (int b = 0; b < 2; ++b)
#pragma unroll
                for (int m = 0; m < 4; ++m)
#pragma unroll
                    for (int n = 0; n < 2; ++n) acc[a][b][m][n] = (f32x4){0.f, 0.f, 0.f, 0.f};
        cur = nxt; cA = nA; cB = nB; chm = nhm; ++ui;
#pragma unroll
        for (int h = 0; h < 2; ++h) { gcur[h][0] = gnxt[h][0]; gcur[h][1] = gnxt[h][1]; }
        if constexpr (ALIGN_EPI) { if (wr == 1) PG8_BAR; }
    }
    PG8_WAIT_V(0);
    if constexpr (!ALIGN_EPI) { if (wr == 0) PG8_BAR; }
    PG8_BAR;
#undef PG8_SA
#undef PG8_SB
#undef PG8_STAGE
#undef PG8_STAGE_A
#undef PG8_GOFF
#undef PG8_LDA
#undef PG8_LDB
#undef PG8_MMA
#undef PG8_WAIT_V
#undef PG8_WAIT_VH
#undef PG8_WAIT_L
#undef PG8_BAR
#undef PG8_SCHED
}
}

namespace att {
using bf16 = __hip_bfloat16;
using bf16x8 = __attribute__((ext_vector_type(8))) short;
using s16x4  = __attribute__((ext_vector_type(4))) short;
using f32x16 = __attribute__((ext_vector_type(16))) float;
using u32x4  = __attribute__((ext_vector_type(4))) unsigned;
constexpr int NW = 8, QBLK = 32, KVBLK = 64;
constexpr float THR = 8.f;
#define SBAR() __builtin_amdgcn_sched_barrier(0)
__device__ __forceinline__ int crow(int r, int hi) { return (r & 3) + 8 * (r >> 2) + 4 * hi; }
__device__ __forceinline__ unsigned cvtpk(float lo, float hi) { unsigned r; asm volatile("v_cvt_pk_bf16_f32 %0, %1, %2" : "=v"(r) : "v"(lo), "v"(hi)); return r; }
typedef __attribute__((address_space(3))) char* lds_p; typedef __attribute__((address_space(3))) const char* lds_cp; typedef __attribute__((address_space(3))) float* lds_fp;
template <int KW> __device__ __forceinline__ int kswz(int row, int cb) {
    if constexpr (KW == 128) return row * 256 + (cb ^ ((row & 15) << 4));
    else return row * 128 + (cb ^ (((row >> 1) & 7) << 4));
}
template <int DV> __device__ __forceinline__ int v_st(int k, int c) { const int kk = k;     return ((kk >> 3) * (DV / 32) + (c >> 5)) * 512 + ((kk & 7) * 32 + (c & 31)) * 2; }
__device__ __forceinline__ int v_rd_base(int lane) { return ((lane & 3) << 3) | (((lane >> 2) & 3) << 6) | (((lane >> 4) & 1) << 5) | (((lane >> 5) & 1) << 8); }
template <int OFF> __device__ __forceinline__ s16x4 tr_read(int vb) { s16x4 r; asm volatile("ds_read_b64_tr_b16 %0, %1 offset:%2" : "=&v"(r) : "v"(vb), "i"(OFF) : "memory"); return r; }

#define MX3(a, b, c) __builtin_fmaxf(__builtin_fmaxf((a), (b)), (c))
__device__ __forceinline__ float rowmax32(const f32x16& p0, const f32x16& p1) {
    float a = MX3(p0[0], p0[1], p1[0]), b = MX3(p0[2], p0[3], p1[1]); a = MX3(a, p1[2], p1[3]);
#pragma unroll
    for (int r = 4; r < 16; r += 4) { a = MX3(a, p0[r], p0[r + 1]); b = MX3(b, p0[r + 2], p0[r + 3]); a = MX3(a, p1[r], p1[r + 1]); b = MX3(b, p1[r + 2], p1[r + 3]); }
    float rm = __builtin_fmaxf(a, b);
    auto rr = __builtin_amdgcn_permlane32_swap(__float_as_uint(rm), __float_as_uint(rm), false, false);
    return __builtin_fmaxf(__uint_as_float(rr[0]), __uint_as_float(rr[1]));
}
#undef MX3
__device__ __forceinline__ void finishSM(f32x16& p0, f32x16& p1, float& l_reg, bf16x8& pa0, bf16x8& pa1, bf16x8& pa2, bf16x8& pa3) {
#pragma unroll
    for (int r = 0; r < 16; ++r) p1[r] = __builtin_amdgcn_exp2f(p1[r]);
    float ps = 0;
#pragma unroll
    for (int r = 0; r < 16; ++r) ps += p0[r];
#pragma unroll
    for (int r = 0; r < 16; ++r) ps += p1[r];
    l_reg += ps;
    u32x4 w0 = {cvtpk(p0[0], p0[1]), cvtpk(p0[2], p0[3]), cvtpk(p0[4], p0[5]), cvtpk(p0[6], p0[7])};
    u32x4 w1 = {cvtpk(p0[8], p0[9]), cvtpk(p0[10], p0[11]), cvtpk(p0[12], p0[13]), cvtpk(p0[14], p0[15])};
    u32x4 w2 = {cvtpk(p1[0], p1[1]), cvtpk(p1[2], p1[3]), cvtpk(p1[4], p1[5]), cvtpk(p1[6], p1[7])};
    u32x4 w3 = {cvtpk(p1[8], p1[9]), cvtpk(p1[10], p1[11]), cvtpk(p1[12], p1[13]), cvtpk(p1[14], p1[15])};
    pa0 = __builtin_bit_cast(bf16x8, w0); pa1 = __builtin_bit_cast(bf16x8, w1); pa2 = __builtin_bit_cast(bf16x8, w2); pa3 = __builtin_bit_cast(bf16x8, w3);
}
template <int KW> __device__ __forceinline__ void qkt(f32x16& p0, f32x16& p1, lds_cp Ks, const bf16x8* qr, const f32x16& c0, const f32x16& c1, int r32, int hi, int kcb) {
#pragma unroll
    for (int d0 = 0; d0 < 4; ++d0) { const int cb = kcb + (d0 * 16 + hi * 8) * 2;
        const bf16x8 b0 = *reinterpret_cast<const __attribute__((address_space(3))) bf16x8*>(Ks + kswz<KW>(r32, cb));
        const bf16x8 b1 = *reinterpret_cast<const __attribute__((address_space(3))) bf16x8*>(Ks + kswz<KW>(32 + r32, cb));
        if (d0 == 0) { p0 = __builtin_amdgcn_mfma_f32_32x32x16_bf16(b0, qr[0], c0, 0, 0, 0); p1 = __builtin_amdgcn_mfma_f32_32x32x16_bf16(b1, qr[0], c1, 0, 0, 0); }
        else { p0 = __builtin_amdgcn_mfma_f32_32x32x16_bf16(b0, qr[d0], p0, 0, 0, 0); p1 = __builtin_amdgcn_mfma_f32_32x32x16_bf16(b1, qr[d0], p1, 0, 0, 0); } }
}
template <int OFF> __device__ __forceinline__ bf16x8 k_read(int addr) { bf16x8 r; asm volatile("ds_read_b128 %0, %1 offset:%2" : "=&v"(r) : "v"(addr), "i"(OFF) : "memory"); return r; }
template <int KW> __device__ __forceinline__ void qkt_batched(f32x16& p0, f32x16& p1, lds_cp Ks, const bf16x8* qr, const f32x16& c0, const f32x16& c1, int r32, int hi, int kcb) {
    constexpr int O2 = 32 * KW * 2;
    const int base = (int)(uintptr_t)Ks;
    const int a0 = base + kswz<KW>(r32, kcb + (0 * 16 + hi * 8) * 2), a1 = base + kswz<KW>(r32, kcb + (1 * 16 + hi * 8) * 2);
    const int a2 = base + kswz<KW>(r32, kcb + (2 * 16 + hi * 8) * 2), a3 = base + kswz<KW>(r32, kcb + (3 * 16 + hi * 8) * 2);
    bf16x8 b0 = k_read<0>(a0), b1 = k_read<O2>(a0), b2 = k_read<0>(a1), b3 = k_read<O2>(a1), b4 = k_read<0>(a2), b5 = k_read<O2>(a2), b6 = k_read<0>(a3), b7 = k_read<O2>(a3);
    asm volatile("s_waitcnt lgkmcnt(6)" : "+v"(b0), "+v"(b1) :: "memory");
    p0 = __builtin_amdgcn_mfma_f32_32x32x16_bf16(b0, qr[0], c0, 0, 0, 0); p1 = __builtin_amdgcn_mfma_f32_32x32x16_bf16(b1, qr[0], c1, 0, 0, 0); SBAR();
    asm volatile("s_waitcnt lgkmcnt(4)" : "+v"(b2), "+v"(b3) :: "memory");
    p0 = __builtin_amdgcn_mfma_f32_32x32x16_bf16(b2, qr[1], p0, 0, 0, 0); p1 = __builtin_amdgcn_mfma_f32_32x32x16_bf16(b3, qr[1], p1, 0, 0, 0); SBAR();
    asm volatile("s_waitcnt lgkmcnt(2)" : "+v"(b4), "+v"(b5) :: "memory");
    p0 = __builtin_amdgcn_mfma_f32_32x32x16_bf16(b4, qr[2], p0, 0, 0, 0); p1 = __builtin_amdgcn_mfma_f32_32x32x16_bf16(b5, qr[2], p1, 0, 0, 0); SBAR();
    asm volatile("s_waitcnt lgkmcnt(0)" : "+v"(b6), "+v"(b7) :: "memory");
    p0 = __builtin_amdgcn_mfma_f32_32x32x16_bf16(b6, qr[3], p0, 0, 0, 0); p1 = __builtin_amdgcn_mfma_f32_32x32x16_bf16(b7, qr[3], p1, 0, 0, 0);
}
template <int KW> __device__ __forceinline__ void qkt_pipe2(f32x16& p0, f32x16& p1, lds_cp Ks, const bf16x8* qr, const f32x16& c0, const f32x16& c1, int r32, int hi, int kcb) {
    constexpr int O2 = 32 * KW * 2;
    const int base = (int)(uintptr_t)Ks;
    const int a0 = base + kswz<KW>(r32, kcb + (0 * 16 + hi * 8) * 2), a1 = base + kswz<KW>(r32, kcb + (1 * 16 + hi * 8) * 2);
    const int a2 = base + kswz<KW>(r32, kcb + (2 * 16 + hi * 8) * 2), a3 = base + kswz<KW>(r32, kcb + (3 * 16 + hi * 8) * 2);
    bf16x8 b0 = k_read<0>(a0), b1 = k_read<O2>(a0), b2 = k_read<0>(a1), b3 = k_read<O2>(a1);
    asm volatile("s_waitcnt lgkmcnt(2)" : "+v"(b0), "+v"(b1) :: "memory");
    p0 = __builtin_amdgcn_mfma_f32_32x32x16_bf16(b0, qr[0], c0, 0, 0, 0); p1 = __builtin_amdgcn_mfma_f32_32x32x16_bf16(b1, qr[0], c1, 0, 0, 0); SBAR();
    b0 = k_read<0>(a2); b1 = k_read<O2>(a2);
    asm volatile("s_waitcnt lgkmcnt(2)" : "+v"(b2), "+v"(b3) :: "memory");
    p0 = __builtin_amdgcn_mfma_f32_32x32x16_bf16(b2, qr[1], p0, 0, 0, 0); p1 = __builtin_amdgcn_mfma_f32_32x32x16_bf16(b3, qr[1], p1, 0, 0, 0); SBAR();
    b2 = k_read<0>(a3); b3 = k_read<O2>(a3);
    asm volatile("s_waitcnt lgkmcnt(2)" : "+v"(b0), "+v"(b1) :: "memory");
    p0 = __builtin_amdgcn_mfma_f32_32x32x16_bf16(b0, qr[2], p0, 0, 0, 0); p1 = __builtin_amdgcn_mfma_f32_32x32x16_bf16(b1, qr[2], p1, 0, 0, 0); SBAR();
    asm volatile("s_waitcnt lgkmcnt(0)" : "+v"(b2), "+v"(b3) :: "memory");
    p0 = __builtin_amdgcn_mfma_f32_32x32x16_bf16(b2, qr[3], p0, 0, 0, 0); p1 = __builtin_amdgcn_mfma_f32_32x32x16_bf16(b3, qr[3], p1, 0, 0, 0);
}
template <int DV, int D0> __device__ __forceinline__ void pv_one(f32x16& od, int vb, bf16x8 pa0, bf16x8 pa1, bf16x8 pa2, bf16x8 pa3) {
    constexpr int KS = (DV / 32) * 1024, HF = (DV / 32) * 512;
    const s16x4 l0 = tr_read<D0 * 512 + 0 * KS>(vb), h0 = tr_read<D0 * 512 + 0 * KS + HF>(vb), l1 = tr_read<D0 * 512 + 1 * KS>(vb), h1 = tr_read<D0 * 512 + 1 * KS + HF>(vb);
    const s16x4 l2 = tr_read<D0 * 512 + 2 * KS>(vb), h2 = tr_read<D0 * 512 + 2 * KS + HF>(vb), l3 = tr_read<D0 * 512 + 3 * KS>(vb), h3 = tr_read<D0 * 512 + 3 * KS + HF>(vb);
    asm volatile("s_waitcnt lgkmcnt(0)" ::: "memory"); SBAR();
#define PK(L, H) (bf16x8){L[0], L[1], L[2], L[3], H[0], H[1], H[2], H[3]}
    od = __builtin_amdgcn_mfma_f32_32x32x16_bf16(pa0, PK(l0, h0), od, 0, 0, 0);
    od = __builtin_amdgcn_mfma_f32_32x32x16_bf16(pa1, PK(l1, h1), od, 0, 0, 0);
    od = __builtin_amdgcn_mfma_f32_32x32x16_bf16(pa2, PK(l2, h2), od, 0, 0, 0);
    od = __builtin_amdgcn_mfma_f32_32x32x16_bf16(pa3, PK(l3, h3), od, 0, 0, 0);
#undef PK
}
struct VF8 { s16x4 l0, h0, l1, h1, l2, h2, l3, h3; };
template <int D0> __device__ __forceinline__ void v_reads128(VF8& f, int vb) {
    constexpr int KS = 4 * 1024, HF = 4 * 512;
    f.l0 = tr_read<D0 * 512 + 0 * KS>(vb); f.h0 = tr_read<D0 * 512 + 0 * KS + HF>(vb); f.l1 = tr_read<D0 * 512 + 1 * KS>(vb); f.h1 = tr_read<D0 * 512 + 1 * KS + HF>(vb);
    f.l2 = tr_read<D0 * 512 + 2 * KS>(vb); f.h2 = tr_read<D0 * 512 + 2 * KS + HF>(vb); f.l3 = tr_read<D0 * 512 + 3 * KS>(vb); f.h3 = tr_read<D0 * 512 + 3 * KS + HF>(vb);
}
__device__ __forceinline__ void v_mfma4(f32x16& od, const VF8& f, bf16x8 pa0, bf16x8 pa1, bf16x8 pa2, bf16x8 pa3) {
#define PK(L, H) (bf16x8){L[0], L[1], L[2], L[3], H[0], H[1], H[2], H[3]}
    od = __builtin_amdgcn_mfma_f32_32x32x16_bf16(pa0, PK(f.l0, f.h0), od, 0, 0, 0);
    od = __builtin_amdgcn_mfma_f32_32x32x16_bf16(pa1, PK(f.l1, f.h1), od, 0, 0, 0);
    od = __builtin_amdgcn_mfma_f32_32x32x16_bf16(pa2, PK(f.l2, f.h2), od, 0, 0, 0);
    od = __builtin_amdgcn_mfma_f32_32x32x16_bf16(pa3, PK(f.l3, f.h3), od, 0, 0, 0);
#undef PK
}
template <int D0> __device__ __forceinline__ void v_reads_lo(VF8& f, int vb) { constexpr int KS = 4 * 1024, HF = 4 * 512;
    f.l0 = tr_read<D0 * 512 + 0 * KS>(vb); f.h0 = tr_read<D0 * 512 + 0 * KS + HF>(vb); f.l1 = tr_read<D0 * 512 + 1 * KS>(vb); f.h1 = tr_read<D0 * 512 + 1 * KS + HF>(vb); }
template <int D0> __device__ __forceinline__ void v_reads_hi(VF8& f, int vb) { constexpr int KS = 4 * 1024, HF = 4 * 512;
    f.l2 = tr_read<D0 * 512 + 2 * KS>(vb); f.h2 = tr_read<D0 * 512 + 2 * KS + HF>(vb); f.l3 = tr_read<D0 * 512 + 3 * KS>(vb); f.h3 = tr_read<D0 * 512 + 3 * KS + HF>(vb); }
#define PK(L, H) (bf16x8){L[0], L[1], L[2], L[3], H[0], H[1], H[2], H[3]}
__device__ __forceinline__ void pv_pipe128(f32x16* o, int vb, bf16x8 pa0, bf16x8 pa1, bf16x8 pa2, bf16x8 pa3) {
    s16x4 al0, ah0, al1, ah1, al2, ah2, al3, ah3, nl0, nh0, nl1, nh1;
    constexpr int KS = 4 * 1024, HF = 4 * 512;
#define RD_LO(D, x0, y0, x1, y1) do { x0 = tr_read<(D) * 512 + 0 * KS>(vb); y0 = tr_read<(D) * 512 + 0 * KS + HF>(vb); x1 = tr_read<(D) * 512 + 1 * KS>(vb); y1 = tr_read<(D) * 512 + 1 * KS + HF>(vb); } while (0)
#define RD_HI(D, x2, y2, x3, y3) do { x2 = tr_read<(D) * 512 + 2 * KS>(vb); y2 = tr_read<(D) * 512 + 2 * KS + HF>(vb); x3 = tr_read<(D) * 512 + 3 * KS>(vb); y3 = tr_read<(D) * 512 + 3 * KS + HF>(vb); } while (0)
#define WAITL(n) do { asm volatile("s_waitcnt lgkmcnt(" #n ")" ::: "memory"); SBAR(); } while (0)
    RD_LO(0, al0, ah0, al1, ah1); RD_HI(0, al2, ah2, al3, ah3); RD_LO(1, nl0, nh0, nl1, nh1);
    WAITL(4);
    o[0] = __builtin_amdgcn_mfma_f32_32x32x16_bf16(pa0, PK(al0, ah0), o[0], 0, 0, 0); o[0] = __builtin_amdgcn_mfma_f32_32x32x16_bf16(pa1, PK(al1, ah1), o[0], 0, 0, 0);
    o[0] = __builtin_amdgcn_mfma_f32_32x32x16_bf16(pa2, PK(al2, ah2), o[0], 0, 0, 0); o[0] = __builtin_amdgcn_mfma_f32_32x32x16_bf16(pa3, PK(al3, ah3), o[0], 0, 0, 0); SBAR();
    RD_HI(1, al2, ah2, al3, ah3); RD_LO(2, al0, ah0, al1, ah1);
    WAITL(8);
    o[1] = __builtin_amdgcn_mfma_f32_32x32x16_bf16(pa0, PK(nl0, nh0), o[1], 0, 0, 0); o[1] = __builtin_amdgcn_mfma_f32_32x32x16_bf16(pa1, PK(nl1, nh1), o[1], 0, 0, 0); SBAR();
    WAITL(4);
    o[1] = __builtin_amdgcn_mfma_f32_32x32x16_bf16(pa2, PK(al2, ah2), o[1], 0, 0, 0); o[1] = __builtin_amdgcn_mfma_f32_32x32x16_bf16(pa3, PK(al3, ah3), o[1], 0, 0, 0); SBAR();
    RD_HI(2, al2, ah2, al3, ah3); RD_LO(3, nl0, nh0, nl1, nh1);
    WAITL(8);
    o[2] = __builtin_amdgcn_mfma_f32_32x32x16_bf16(pa0, PK(al0, ah0), o[2], 0, 0, 0); o[2] = __builtin_amdgcn_mfma_f32_32x32x16_bf16(pa1, PK(al1, ah1), o[2], 0, 0, 0); SBAR();
    WAITL(4);
    o[2] = __builtin_amdgcn_mfma_f32_32x32x16_bf16(pa2, PK(al2, ah2), o[2], 0, 0, 0); o[2] = __builtin_amdgcn_mfma_f32_32x32x16_bf16(pa3, PK(al3, ah3), o[2], 0, 0, 0); SBAR();
    RD_HI(3, al2, ah2, al3, ah3);
    WAITL(4);
    o[3] = __builtin_amdgcn_mfma_f32_32x32x16_bf16(pa0, PK(nl0, nh0), o[3], 0, 0, 0); o[3] = __builtin_amdgcn_mfma_f32_32x32x16_bf16(pa1, PK(nl1, nh1), o[3], 0, 0, 0); SBAR();
    WAITL(0);
    o[3] = __builtin_amdgcn_mfma_f32_32x32x16_bf16(pa2, PK(al2, ah2), o[3], 0, 0, 0); o[3] = __builtin_amdgcn_mfma_f32_32x32x16_bf16(pa3, PK(al3, ah3), o[3], 0, 0, 0);
#undef RD_LO
#undef RD_HI
#undef WAITL
}
#undef PK
template <int DV> __device__ __forceinline__ void pv_all(f32x16* o, int vb, bf16x8 pa0, bf16x8 pa1, bf16x8 pa2, bf16x8 pa3) {
    if constexpr (DV == 128) { pv_pipe128(o, vb, pa0, pa1, pa2, pa3); return; }
    pv_one<DV, 0>(o[0], vb, pa0, pa1, pa2, pa3); pv_one<DV, 1>(o[1], vb, pa0, pa1, pa2, pa3);
    if constexpr (DV == 128) { pv_one<DV, 2>(o[2], vb, pa0, pa1, pa2, pa3); pv_one<DV, 3>(o[3], vb, pa0, pa1, pa2, pa3); }
}

struct UnitArgs {
    const bf16* Qw; int ldq;
    const bf16* Kh; const bf16* Vh; int ldk;
    int NT;
    int kcol;
    bf16* Ow; int ldo;
    int na_kr0, na_rq, na_c0; const float* rpb;
    float lam; const float* subg; float oscale;
};
constexpr int NA_TAB_FLOATS = 16 * 128;

template <int DV, int KW, int MODE>
__device__ __forceinline__ void attn_unit(const UnitArgs& a, char* lds, const int tid) {
    constexpr int SHM_V = KVBLK * DV * 2, SHM_K = KVBLK * KW * 2, SLOT = SHM_V + SHM_K;
    constexpr int NS = (DV == 128) ? 4 : 8, PD = NS - 1, PER = DV / 64 + KW / 64, RING = NS * SLOT;
    const int wid = __builtin_amdgcn_readfirstlane(tid >> 6), lane = tid & 63, r32 = lane & 31, hi = lane >> 5;
    const lds_p ldsa = (lds_p)lds;
    lds_fp ws = (lds_fp)(ldsa + RING) + wid * 64; lds_fp li_l = ws; lds_fp al_l = ws + 32;
    lds_fp tab = (lds_fp)(ldsa + RING + NW * 64 * 4);
    float mhat = 0.f, l_reg = 0.f; f32x16 o[DV / 32]; bf16x8 qr[4]; f32x16 negm = f32x16{};
#pragma unroll
    for (int d = 0; d < DV / 32; ++d) o[d] = f32x16{};
    const bf16* Qw = a.Qw + (long)r32 * a.ldq + hi * 8;
#pragma unroll
    for (int d0 = 0; d0 < 4; ++d0) qr[d0] = *reinterpret_cast<const bf16x8*>(Qw + d0 * 16);
    typedef __attribute__((address_space(3))) unsigned lds_u32;
    const int kcb = a.kcol * 2;
    const bf16* Vh = a.Vh; const bf16* Kh = a.Kh; const int ldk = a.ldk;
    unsigned koffA, koffB = 0u, voffA, voffB = 0u;
    { auto ksrc = [&](int ch) -> unsigned { const int p = ch * 1024 + lane * 16; constexpr int RB = KW * 2; const int row = p / RB, slot = (p % RB) >> 4;
          const int c = slot ^ ((KW == 128) ? (row & 15) : ((row >> 1) & 7)); return (unsigned)(row * ldk + c * 8) * 2u; };
      auto vsrc = [&](int ch) -> unsigned { const int p = ch * 1024 + lane * 16; constexpr int NB = DV / 32; const int sub = p >> 9, kkh = sub / NB, cblk = sub % NB, within = p & 511;
          const int key = kkh * 8 + (within >> 6), col = cblk * 32 + ((within & 63) >> 4) * 8; return (unsigned)(key * ldk + col) * 2u; };
      koffA = ksrc(wid); voffA = vsrc(wid); if constexpr (KW == 128) koffB = ksrc(wid + 8); if constexpr (DV == 128) voffB = vsrc(wid + 8); }
    const int vb0 = (int)(uintptr_t)lds + v_rd_base(lane);
    lds_u32* ldsl = (lds_u32*)(__attribute__((address_space(3))) char*)lds;
#define KROW(t) ((MODE == 2) ? (((t) < 4) ? (t) * 64 : (NCTX + (na_kr0 + (t) - 4) * 64)) : (t) * KVBLK)
    const int na_kr0 = a.na_kr0;
#define GLDS(gp_, byteoff_) __builtin_amdgcn_global_load_lds((const unsigned*)(gp_), (lds_u32*)((__attribute__((address_space(3))) char*)ldsl + (byteoff_)), 16, 0, 0)
#define DMA(t_) do { const int k0_ = KROW(t_); const int sl_ = ((t_) % NS) * SLOT; \
    const char* vt_ = (const char*)Vh + (size_t)k0_ * ldk * 2; const char* kt_ = (const char*)Kh + (size_t)k0_ * ldk * 2; \
    const int vd_ = sl_ + wid * 1024, kd_ = sl_ + SHM_V + wid * 1024; \
    GLDS(kt_ + koffA, kd_); if constexpr (KW == 128) GLDS(kt_ + koffB, kd_ + 8192); \
    GLDS(vt_ + voffA, vd_); if constexpr (DV == 128) GLDS(vt_ + voffB, vd_ + 8192); } while (0)
#define KBUF(t_) ((lds_cp)ldsa + (((t_) % NS) * SLOT + SHM_V))
#define VBUF(t_) (vb0 + ((t_) % NS) * SLOT)
    int na_c = 0, na_cs = 0, na_rs = 0;
    if constexpr (MODE == 2) {
        na_c = a.na_c0 + r32; na_cs = na_c - 8; na_cs = na_cs < 0 ? 0 : (na_cs > 48 ? 48 : na_cs);
        na_rs = a.na_rq - 4; na_rs = na_rs < 0 ? 0 : (na_rs > 248 ? 248 : na_rs);
        static_assert(NA_TAB_FLOATS == 4 * 512, "table build: four entries per thread");
        float tv[4];
#pragma unroll
        for (int it = 0; it < 4; ++it) { const int i = tid + 512 * it; const int dri = i >> 7, x = (i & 127) - 48; const bool in_ = (dri < 15) && (x >= 0) && (x < 31);
            const float b = a.rpb[in_ ? dri * 31 + x : 0];
            tv[it] = (dri == 15) ? -INFINITY : (in_ ? b * LOG2E : 0.f); }
#pragma unroll
        for (int it = 0; it < 4; ++it) tab[tid + 512 * it] = tv[it];
    }
    f32x16 cm0 = f32x16{}, cm1 = f32x16{};
#define NA_MASKC() do { const int vb_ = 4 * hi - na_cs; _Pragma("unroll") for (int r = 0; r < 16; ++r) { const int kc_ = (r & 3) + 8 * (r >> 2); \
        cm0[r] = ((unsigned)(vb_ + kc_) < 16u) ? cm0[r] : -INFINITY; cm1[r] = ((unsigned)(vb_ + kc_ + 32) < 16u) ? cm1[r] : -INFINITY; } } while (0)
#define NABIAS(P0, P1, t_) do { const int dri_ = na_kr0 + (t_) - 4 - a.na_rq + 7; const __attribute__((address_space(3))) float* tb_ = tab + dri_ * 128 + (63 - na_c + 4 * hi); \
        _Pragma("unroll") for (int r = 0; r < 16; ++r) { const int kc_ = (r & 3) + 8 * (r >> 2); P0[r] += tb_[kc_]; P1[r] += tb_[kc_ + 32]; } } while (0)
#define PARTIAL(P0, P1, FIRST) do { const float rm_ = rowmax32(P0, P1); const bool fst_ = (FIRST); \
    if (fst_ || __builtin_expect(__any(rm_ > THR), 0)) { const float dl_ = fst_ ? rm_ : __builtin_fmaxf(rm_, 0.f); mhat += dl_; \
        _Pragma("unroll") for (int r = 0; r < 16; ++r) { P0[r] -= dl_; P1[r] -= dl_; } \
        if constexpr (MODE == 2) { _Pragma("unroll") for (int r = 0; r < 16; ++r) { cm0[r] -= dl_; cm1[r] -= dl_; } } else { _Pragma("unroll") for (int r = 0; r < 16; ++r) negm[r] = -mhat; } \
        if (!fst_) { const float f_ = __builtin_amdgcn_exp2f(-dl_); l_reg *= f_; if (hi == 0) al_l[r32] = f_; asm volatile("s_waitcnt lgkmcnt(0)" ::: "memory"); \
            _Pragma("unroll") for (int d = 0; d < DV / 32; ++d) _Pragma("unroll") for (int r = 0; r < 16; ++r) o[d][r] *= al_l[crow(r, hi)]; } } \
    _Pragma("unroll") for (int r = 0; r < 16; ++r) P0[r] = __builtin_amdgcn_exp2f(P0[r]); } while (0)
    f32x16 pA0, pA1, pB0, pB1; bf16x8 pa0, pa1, pa2, pa3; const int NST = a.NT >> 1;
    const bool lead = wid < 4;
    unsigned vmask = 0xffffffffu;
    if constexpr (MODE == 2) { vmask = 0xfu; for (int t = 4; t < 16; ++t) if ((unsigned)(na_kr0 + t - 4 - na_rs) < 8u) vmask |= 1u << t; vmask = (unsigned)__builtin_amdgcn_readfirstlane((int)vmask); }
#define TV(t_) ((MODE != 2) || ((vmask >> (t_)) & 1u))
    const int NT = a.NT;
#define WAITV(n_) asm volatile("s_waitcnt vmcnt(%0)" :: "n"(n_) : "memory")
#define STEPBAR(t_) do { if ((t_) + PD - 1 < NT) { WAITV((PD - 2) * PER); } else { WAITV(0); } asm volatile("s_waitcnt lgkmcnt(0)\n\ts_barrier" ::: "memory"); } while (0)
#define RSTEP(PX0, PX1, PY0, PY1, t_, GRID_) do { const int tt_ = (t_); const bool vx_ = TV(tt_), vy_ = (tt_ + 1 < NT) && TV(tt_ + 1); \
    STEPBAR(tt_); \
    SBAR(); if (!lead && vx_) { PARTIAL(PX0, PX1, tt_ == 0); } SBAR(); \
    if (vy_) { __builtin_amdgcn_s_setprio(1); if constexpr (MODE == 2) { qkt_batched<KW>(PY0, PY1, KBUF(tt_ + 1), qr, cm0, cm1, r32, hi, kcb); } else if constexpr (MODE == 0) { qkt_batched<KW>(PY0, PY1, KBUF(tt_ + 1), qr, negm, negm, r32, hi, kcb); } else { qkt_pipe2<KW>(PY0, PY1, KBUF(tt_ + 1), qr, negm, negm, r32, hi, kcb); } __builtin_amdgcn_s_setprio(0); \
        if constexpr (GRID_) { NABIAS(PY0, PY1, tt_ + 1); } } SBAR(); \
    if (tt_ + PD < NT) { DMA(tt_ + PD); } SBAR();     \
    if (vx_) { finishSM(PX0, PX1, l_reg, pa0, pa1, pa2, pa3); SBAR(); __builtin_amdgcn_s_setprio(1); pv_all<DV>(o, VBUF(tt_), pa0, pa1, pa2, pa3); __builtin_amdgcn_s_setprio(0); } SBAR(); \
    if (lead && vy_) { PARTIAL(PY0, PY1, false); } SBAR(); } while (0)
#pragma unroll
    for (int t = 0; t < PD; ++t) if (t < NT) DMA(t);
    if (NT >= PD) { WAITV((PD - 1) * PER); } else { WAITV(0); }
    asm volatile("s_waitcnt lgkmcnt(0)\n\ts_barrier" ::: "memory");
    if constexpr (MODE == 2) { qkt<KW>(pA0, pA1, KBUF(0), qr, cm0, cm1, r32, hi, kcb); } else { qkt<KW>(pA0, pA1, KBUF(0), qr, negm, negm, r32, hi, kcb); }
    if (lead) { PARTIAL(pA0, pA1, true); }
    if constexpr (MODE == 2) {
        RSTEP(pA0, pA1, pB0, pB1, 0, false); RSTEP(pB0, pB1, pA0, pA1, 1, false); RSTEP(pA0, pA1, pB0, pB1, 2, false); NA_MASKC(); RSTEP(pB0, pB1, pA0, pA1, 3, true);
        for (int t = 4; t < NT; t += 2) { RSTEP(pA0, pA1, pB0, pB1, t, true); RSTEP(pB0, pB1, pA0, pA1, t + 1, true); }
    } else {
        for (int t = 0; t < NT; t += 2) { RSTEP(pA0, pA1, pB0, pB1, t, false); RSTEP(pB0, pB1, pA0, pA1, t + 1, false); }
    }
    asm volatile("s_waitcnt vmcnt(0) lgkmcnt(0)\n\ts_barrier" ::: "memory");
    { auto rr = __builtin_amdgcn_permlane32_swap(__float_as_uint(l_reg), __float_as_uint(l_reg), false, false); l_reg = __uint_as_float(rr[0]) + __uint_as_float(rr[1]); }
    if (hi == 0) li_l[r32] = l_reg; asm volatile("s_waitcnt lgkmcnt(0)" ::: "memory");
    int lane_e = (int)__builtin_amdgcn_mbcnt_hi(~0u, __builtin_amdgcn_mbcnt_lo(~0u, 0u)); asm volatile("" : "+v"(lane_e));
    const int r32e = lane_e & 31, hie = lane_e >> 5;
    float rli[16];
#pragma unroll
    for (int r = 0; r < 16; ++r) rli[r] = __builtin_amdgcn_rcpf(li_l[crow(r, hie)]);
    unsigned short* Owp = (unsigned short*)a.Ow; const unsigned ldo = (unsigned)a.ldo;
    if constexpr (MODE != 1) {
#pragma unroll
        for (int r = 0; r < 16; ++r) { const unsigned orow = (unsigned)crow(r, hie);
#pragma unroll
            for (int d0 = 0; d0 < DV / 32; ++d0) Owp[orow * ldo + (unsigned)(d0 * 32 + r32e)] = (unsigned short)(cvtpk(o[d0][r] * rli[r], 0.f) & 0xffffu); }
    } else {
#pragma unroll
        for (int d = 0; d < DV / 32; ++d)
#pragma unroll
            for (int r = 0; r < 16; ++r) o[d][r] *= rli[r];
        lds_fp X = (lds_fp)ldsa;
        if (wid >= 4) {
#pragma unroll
            for (int d = 0; d < DV / 32; ++d)
#pragma unroll
                for (int r = 0; r < 16; ++r) X[(((wid - 4) * 4 + d) * 16 + r) * 64 + lane_e] = o[d][r];
        }
        __syncthreads();
        if (wid < 4) {
#pragma unroll
            for (int d = 0; d < DV / 32; ++d) {
#pragma unroll
                for (int r = 0; r < 16; ++r) o[d][r] -= a.lam * X[((wid * 4 + d) * 16 + r) * 64 + lane_e];
                asm volatile("" ::: "memory"); }
            float sg[DV / 32];
#pragma unroll
            for (int d = 0; d < DV / 32; ++d) sg[d] = a.subg[d * 32 + r32e] * a.oscale;
#pragma unroll
            for (int r = 0; r < 16; ++r) { float ss = 0.f;
#pragma unroll
                for (int d = 0; d < DV / 32; ++d) ss += o[d][r] * o[d][r];
                ss += __shfl_xor(ss, 1); ss += __shfl_xor(ss, 2); ss += __shfl_xor(ss, 4); ss += __shfl_xor(ss, 8); ss += __shfl_xor(ss, 16);
                const float rn = __builtin_amdgcn_rsqf(ss * (1.f / 128.f) + 1e-6f); const unsigned orow = (unsigned)crow(r, hie);
#pragma unroll
                for (int d = 0; d < DV / 32; ++d) Owp[orow * ldo + (unsigned)(d * 32 + r32e)] = (unsigned short)(cvtpk(o[d][r] * rn * sg[d], 0.f) & 0xffffu); }
        }
        __syncthreads();
    }
#undef KROW
#undef GLDS
#undef DMA
#undef KBUF
#undef VBUF
#undef NABIAS
#undef NA_MASKC
#undef PARTIAL
#undef TV
#undef WAITV
#undef STEPBAR
#undef RSTEP
}
#undef SBAR
constexpr int ATT_LDS_MAX = 4 * (64 * 128 * 2 * 2) + NW * 64 * 4 + NA_TAB_FLOATS * 4;
}

constexpr int NWAVES = 8;
constexpr size_t MiB = 1u << 20;
constexpr size_t WS_CTL = 0, CTL_ZERO_BYTES = 1 * MiB;
constexpr size_t WS_MODV = 1 * MiB;
constexpr size_t WS_ROPE = 1 * MiB + 256 * 1024;
constexpr size_t WS_ROUTE = 2 * MiB;
constexpr size_t WS_ROWTOK = 3 * MiB;
constexpr size_t WS_ROWW = 3 * MiB + 256 * 1024;
constexpr size_t WS_TILEEXP = 3 * MiB + 512 * 1024;
constexpr size_t WS_WINE = 4 * MiB, WS_WOUTE = 13 * MiB, WS_WINO = 17 * MiB, WS_WOUTO = 29 * MiB, WS_W13 = 33 * MiB, WS_W2 = 289 * MiB;
constexpr size_t WS_X = 417 * MiB, WS_HB = 482 * MiB, WS_QKV = 515 * MiB, WS_AS = WS_QKV, WS_ELIST = WS_QKV, WS_EWT = WS_QKV + 4 * MiB, WS_AO = 613 * MiB, WS_MIX = 646 * MiB, WS_HMID = WS_AO, WS_Y = 679 * MiB, WS_END = 744 * MiB;
static_assert(WS_X + (size_t)M * D * 4 <= WS_HB && WS_HB + (size_t)M * D * 2 <= WS_QKV && WS_QKV + (size_t)M * ODD_IN * 2 <= WS_AO && WS_AS + (size_t)AS_ROWS * D * 2 <= WS_AO, "ws map 1");
static_assert(WS_AO + (size_t)M * D * 2 <= WS_MIX && WS_MIX + (size_t)M * D * 2 <= WS_Y && WS_HMID + (size_t)AS_ROWS * DE * 2 <= WS_Y && WS_Y + (size_t)2 * M * D * 2 <= WS_END, "ws map 2");
static_assert(WS_W13 + (size_t)DEPTH * NE * 1024 * 1024 * 2 <= WS_W2 && WS_W2 + (size_t)DEPTH * NE * 1024 * 512 * 2 <= WS_X, "ws map 3");
constexpr int CW_TMO = 0, CW_CODE = 1, CW_BAR = 4096, CW_CNT = 16384;
constexpr int LDS_BYTES = 163840, MISC_OFF = LDS_BYTES - 256;
constexpr int RT_BYTES = 36 * 1024 * 4;
constexpr int LN1_MAXREC = 192;
constexpr int MOE_TAB_OFF = 131072;
static_assert(RT_BYTES + 2048 + 512 + LN1_MAXREC * 16 <= MISC_OFF && att::ATT_LDS_MAX <= MISC_OFF && pg8::STAGE_BYTES <= MISC_OFF, "LDS map");

#define LAS __attribute__((address_space(3)))
typedef unsigned short bf16;
typedef unsigned v4u __attribute__((ext_vector_type(4)));
typedef unsigned v2u __attribute__((ext_vector_type(2)));
typedef float v2f __attribute__((ext_vector_type(2)));
typedef float f32x4 __attribute__((ext_vector_type(4)));
#define RLX_AGENT __ATOMIC_RELAXED, __HIP_MEMORY_SCOPE_AGENT
#define LDS_WAIT() asm volatile("s_waitcnt lgkmcnt(0)" ::: "memory")
#define VM_WAIT() asm volatile("s_waitcnt vmcnt(0)" ::: "memory")
__device__ __forceinline__ unsigned f2bf(float f) { unsigned u = __builtin_bit_cast(unsigned, f); return (u + 0x7fffu + ((u >> 16) & 1u)) >> 16; }
__device__ __forceinline__ unsigned pk2(float lo, float hi) { unsigned r; asm("v_cvt_pk_bf16_f32 %0, %1, %2" : "=v"(r) : "v"(lo), "v"(hi)); return r; }
__device__ __forceinline__ float bf_lo(unsigned w) { return __builtin_bit_cast(float, w << 16); }
__device__ __forceinline__ float bf_hi(unsigned w) { return __builtin_bit_cast(float, w & 0xffff0000u); }
__device__ __forceinline__ unsigned pkh2(float lo, float hi) { return (unsigned)__builtin_bit_cast(unsigned short, (_Float16)lo) | ((unsigned)__builtin_bit_cast(unsigned short, (_Float16)hi) << 16); }
__device__ __forceinline__ float h_lo(unsigned w) { return (float)__builtin_bit_cast(_Float16, (unsigned short)(w & 0xffffu)); }
__device__ __forceinline__ float h_hi(unsigned w) { return (float)__builtin_bit_cast(_Float16, (unsigned short)(w >> 16)); }

#define XB_TMO      128
#define XB_XCNT(j)  (256  + 64 * (j))
#define XB_XSUB(j)  (1280 + 64 * (j))
#define XB_XGEN(j)  (2304 + 64 * (j))
#define XB_TOP      3328
#define XB_TOPGEN   3392
#define XCD_BAR_WORDS 3456
#define XB_SPIN_CAP (1u << 21)
__device__ __forceinline__ unsigned xb_ld(unsigned* p)              { return __hip_atomic_load(p, __ATOMIC_RELAXED, __HIP_MEMORY_SCOPE_AGENT); }
__device__ __forceinline__ unsigned xb_add(unsigned* p, unsigned v) { return __hip_atomic_fetch_add(p, v, __ATOMIC_RELAXED, __HIP_MEMORY_SCOPE_AGENT); }
__device__ __forceinline__ unsigned xb_xcc_id() { return (unsigned)__builtin_amdgcn_s_getreg((3 << 11) | 20) & 0xFu; }
#define XB_SPIN(cond, bar) do { unsigned _sp = 0; while (cond) { __builtin_amdgcn_s_sleep(1); \
    if ((++_sp & 255u) == 0u) { if (xb_ld(&(bar)[XB_TMO])) break; if (_sp > XB_SPIN_CAP) { atomicAdd(&(bar)[XB_TMO], 1u); break; } } } } while (0)
struct XcdBarrier { unsigned* bar; unsigned x; volatile LAS unsigned* st; };
__device__ __forceinline__ XcdBarrier xcd_barrier_post(unsigned* bar, volatile LAS unsigned* st) {
    XcdBarrier b; b.bar = bar; b.x = xb_xcc_id(); b.st = st;
    if (threadIdx.x == 0) (void)xb_add(&bar[XB_XCNT(b.x)], 1u);
    return b;
}
__device__ __forceinline__ void xcd_barrier_complete(unsigned* bar, unsigned x, unsigned& nloc, unsigned& nx) {
    const unsigned G = gridDim.x * gridDim.y * gridDim.z;
    unsigned sum, cnt, mine, sp = 0u;
    for (;;) {
        sum = 0u; cnt = 0u; mine = 0u;
#pragma unroll
        for (unsigned j = 0; j < 16; ++j) { const unsigned c = xb_ld(&bar[XB_XCNT(j)]); sum += c; cnt += (c > 0u) ? 1u : 0u; mine = (j == x) ? c : mine; }
        if (sum == G) break;
        __builtin_amdgcn_s_sleep(1);
        if ((++sp & 255u) == 0u) { if (xb_ld(&bar[XB_TMO])) break; if (sp > XB_SPIN_CAP) { atomicAdd(&bar[XB_TMO], 1u); break; } }
    }
    nloc = mine > 0u ? mine : 1u; nx = cnt > 0u ? cnt : 1u;
}
__device__ __forceinline__ void xcd_barrier(const XcdBarrier& b) {
    asm volatile("s_waitcnt vmcnt(0)" ::: "memory");
    __syncthreads();
    if (threadIdx.x == 0) {
        unsigned* bar = b.bar;
        __builtin_amdgcn_s_waitcnt(0);
        unsigned nloc = b.st[0], nx = b.st[1];
        if (nloc == 0u) { xcd_barrier_complete(bar, b.x, nloc, nx); b.st[0] = nloc; b.st[1] = nx; }
        const unsigned old = xb_add(&bar[XB_XSUB(b.x)], 1u);
        const unsigned gen = old / nloc;
        if (old + 1u == (gen + 1u) * nloc) {
            __builtin_amdgcn_fence(__ATOMIC_RELEASE, "agent");
            asm volatile("s_waitcnt vmcnt(0)" ::: "memory");
            const unsigned og = xb_add(&bar[XB_TOP], 1u);
            const unsigned tg = og / nx;
            if (og + 1u == (tg + 1u) * nx) xb_add(&bar[XB_TOPGEN], 1u);
            else XB_SPIN(xb_ld(&bar[XB_TOPGEN]) == tg, bar);
            __builtin_amdgcn_fence(__ATOMIC_ACQUIRE, "agent");
            xb_add(&bar[XB_XGEN(b.x)], 1u);
            asm volatile("s_waitcnt vmcnt(0)" ::: "memory");
        } else {
            XB_SPIN(xb_ld(&bar[XB_XGEN(b.x)]) == gen, bar);
            __builtin_amdgcn_fence(__ATOMIC_ACQUIRE, "agent");
            asm volatile("s_waitcnt vmcnt(0)" ::: "memory");
        }
    }
    __syncthreads();
}

__device__ __forceinline__ int launder_i(int v) { asm volatile("" : "+v"(v)); return __builtin_amdgcn_readfirstlane(v); }
template <class T> __device__ __forceinline__ T* launder_p(T* p) { const unsigned long long v = (unsigned long long)p; unsigned lo = (unsigned)v, hi = (unsigned)(v >> 32);
    asm volatile("" : "+v"(lo), "+v"(hi)); lo = (unsigned)__builtin_amdgcn_readfirstlane((int)lo); hi = (unsigned)__builtin_amdgcn_readfirstlane((int)hi); return (T*)(((unsigned long long)hi << 32) | lo); }
struct Args { const float* in[21]; float* out; unsigned char* ws; int ph_lo, ph_hi; };
enum { I_X = 0, I_C, I_CTX, I_CCTX, I_WMOD, I_BMOD, I_LNG, I_LNB, I_WINE, I_WOUTE, I_DLAM, I_SUBG, I_QKG, I_WINO, I_WOUTO, I_RPB, I_RG, I_RE, I_W1, I_W3, I_W2 };

struct Frame {
    LAS unsigned char* lds; unsigned char* ldsg; unsigned char* ws;
    int tid, lane, wave, vcu, G, gw, NGW, bx;
    const float* const* in;
};
__device__ __forceinline__ float wave_sum(float v) {
#pragma unroll
    for (int o = 1; o < 64; o <<= 1) v += __shfl_xor(v, o);
    return v;
}
__device__ __forceinline__ const float* modv(const Frame& F, int l, int s, int v) { return (const float*)(F.ws + WS_MODV) + ((size_t)(l * 2 + s) * 6 + v) * D; }
__device__ __forceinline__ const float* xrow_in(const Frame& F, int l, int r) {
    return (r < NCTX) ? F.in[I_CTX] + (size_t)r * D : F.in[I_X] + (size_t)(r - NCTX) * D;
}

__device__ __forceinline__ void transpose_item(const float* W, int K, int N, bf16* WT, int k0, int n0, int dst_row0, LAS float* scr, int lane) {
#pragma unroll 8
    for (int i = 0; i < 32; ++i) { const int kk = 2 * i + (lane >> 5); scr[kk * 33 + (lane & 31)] = W[(size_t)(k0 + kk) * N + n0 + (lane & 31)]; }
    LDS_WAIT(); asm volatile("" ::: "memory");
    const int c = lane & 7;
#pragma unroll
    for (int j = 0; j < 4; ++j) { const int n = (lane >> 3) + 8 * j; const LAS float* s = scr + (8 * c) * 33 + n;
        v4u o; o.x = pk2(s[0 * 33], s[1 * 33]); o.y = pk2(s[2 * 33], s[3 * 33]); o.z = pk2(s[4 * 33], s[5 * 33]); o.w = pk2(s[6 * 33], s[7 * 33]);
        *(v4u*)(WT + (size_t)(dst_row0 + n) * K + k0 + 8 * c) = o; }
    LDS_WAIT(); asm volatile("" ::: "memory");
}
__device__ __forceinline__ void p0a(Frame& F) {
#ifndef DBG_P0
#define DBG_P0 7
#endif
    if (DBG_P0 & 1) {
        LAS float* sv = (LAS float*)F.lds;
        LAS float* red = (LAS float*)(F.lds + 8192);
        for (int k = F.tid; k < D; k += 512) { const float a = F.in[I_C][k], b = F.in[I_CCTX][k];
            sv[k] = a / (1.f + expf(-a)); sv[D + k] = b / (1.f + expf(-b)); }
        __syncthreads();
        for (int grp = F.bx; grp < DEPTH * 192; grp += F.G) {
            const int l = grp / 192, col = (grp % 192) * 32 + (F.lane & 31), kh = F.lane >> 5;
            const float* W = F.in[I_WMOD] + ((size_t)l * D + F.wave * 128 + kh * 64) * (6 * D) + col;
            float a0 = 0.f, a1 = 0.f;
#pragma unroll 16
            for (int kk = 0; kk < 64; ++kk) { const float w = W[(size_t)kk * (6 * D)]; a0 += sv[F.wave * 128 + kh * 64 + kk] * w; a1 += sv[D + F.wave * 128 + kh * 64 + kk] * w; }
            a0 += __shfl_xor(a0, 32); a1 += __shfl_xor(a1, 32);
            if (F.lane < 32) { red[(F.wave * 64 + F.lane) * 2 + 0] = a0; red[(F.wave * 64 + F.lane) * 2 + 1] = a1; }
            __syncthreads();
            if (F.wave == 0 && F.lane < 32) { float s0 = 0.f, s1 = 0.f;
#pragma unroll
                for (int w = 0; w < 8; ++w) { s0 += red[(w * 64 + F.lane) * 2 + 0]; s1 += red[(w * 64 + F.lane) * 2 + 1]; }
                const float bm = F.in[I_BMOD][(size_t)l * 6 * D + col];
                float* mv = (float*)(F.ws + WS_MODV);
                mv[((size_t)(l * 2 + 0) * 6) * D + col] = s0 + bm; mv[((size_t)(l * 2 + 1) * 6) * D + col] = s1 + bm; }
            __syncthreads();
        }
    }
    if (DBG_P0 & 2) { const int gt = F.bx * 512 + F.tid;
      if (gt < 256 * 16) { const int pos = gt >> 4, i = gt & 15; const double inv = pow(10000.0, -(double)i / 16.0), ang = (double)pos * inv;
          float* rt = (float*)(F.ws + WS_ROPE); rt[gt * 2 + 0] = (float)cos(ang); rt[gt * 2 + 1] = (float)sin(ang); } }
    LAS float* scr = (LAS float*)(F.lds + 16384 + F.wave * 8704);
    constexpr int I_INE = 16 * 72, I_OUT = 16 * 32, I_INO = 16 * 96, T_W1 = 16 * 16, T_W2 = 8 * 32;
    constexpr int N_A = 2 * I_INE, N_B = N_A + 2 * I_OUT, N_C = N_B + 2 * I_INO, N_D = N_C + 2 * I_OUT, N_E = N_D + 128 * T_W1, N_F = N_E + 128 * T_W1, N_G = N_F + 128 * T_W2;
    if (DBG_P0 & 4) for (int it = F.gw; it < N_G; it += F.NGW) {
        if (it < N_A) { const int i = it / I_INE, r = it % I_INE, kb = r / 72, nb = r % 72;
            transpose_item(F.in[I_WINE] + (size_t)i * D * EVEN_IN, D, EVEN_IN, (bf16*)(F.ws + WS_WINE) + (size_t)i * EVEN_IN * D, 64 * kb, 32 * nb, 32 * nb, scr, F.lane); }
        else if (it < N_B) { const int q = it - N_A, i = q / I_OUT, r = q % I_OUT, kb = r / 32, nb = r % 32;
            transpose_item(F.in[I_WOUTE] + (size_t)i * D * D, D, D, (bf16*)(F.ws + WS_WOUTE) + (size_t)i * D * D, 64 * kb, 32 * nb, 32 * nb, scr, F.lane); }
        else if (it < N_C) { const int q = it - N_B, i = q / I_INO, r = q % I_INO, kb = r / 96, nb = r % 96;
            transpose_item(F.in[I_WINO] + (size_t)i * D * ODD_IN, D, ODD_IN, (bf16*)(F.ws + WS_WINO) + (size_t)i * ODD_IN * D, 64 * kb, 32 * nb, 32 * nb, scr, F.lane); }
        else if (it < N_D) { const int q = it - N_C, i = q / I_OUT, r = q % I_OUT, kb = r / 32, nb = r % 32;
            transpose_item(F.in[I_WOUTO] + (size_t)i * D * D, D, D, (bf16*)(F.ws + WS_WOUTO) + (size_t)i * D * D, 64 * kb, 32 * nb, 32 * nb, scr, F.lane); }
        else if (it < N_F) { const bool is3 = it >= N_E; const int q = it - (is3 ? N_E : N_D), le = q / T_W1, r = q % T_W1, kb = r / 16, nb = r % 16, n0 = 32 * nb;
            transpose_item(F.in[is3 ? I_W3 : I_W1] + (size_t)le * D * DE, D, DE, (bf16*)(F.ws + WS_W13) + (size_t)le * 1024 * D, 64 * kb, n0, (n0 >> 7) * 256 + (is3 ? 128 : 0) + (n0 & 127), scr, F.lane); }
        else { const int q = it - N_F, le = q / T_W2, r = q % T_W2, kb = r / 32, nb = r % 32;
            transpose_item(F.in[I_W2] + (size_t)le * DE * D, DE, D, (bf16*)(F.ws + WS_W2) + (size_t)le * D * DE, 64 * kb, 32 * nb, 32 * nb, scr, F.lane); }
    }
}
__device__ __forceinline__ void p0b(Frame& F) {
    f32x4 xn[2][4];
#define P0B_LOAD(b_, r_) do { const f32x4* xr_ = (const f32x4*)xrow_in(F, 0, (r_)) + F.lane; _Pragma("unroll") for (int j = 0; j < 4; ++j) xn[b_][j] = xr_[64 * j]; } while (0)
#pragma unroll 1
    for (int pass = 0; pass < 2; ++pass) {
        const int s = 1 - pass;
        const int rfirst = pass ? NCTX + F.gw : (F.wave == 0 ? F.vcu : NCTX), rstep = pass ? F.NGW : F.G, rend = pass ? M : NCTX;
        if (rfirst >= rend) continue;
        f32x4 psc[4], psh[4];
        { const f32x4* sh = (const f32x4*)modv(F, 0, s, 0) + F.lane; const f32x4* sc = (const f32x4*)modv(F, 0, s, 1) + F.lane;
#pragma unroll
          for (int j = 0; j < 4; ++j) { psc[j] = sc[64 * j] + 1.f; psh[j] = sh[64 * j]; } }
        P0B_LOAD(0, rfirst); if (rfirst + rstep < rend) P0B_LOAD(1, rfirst + rstep);
#pragma unroll 1
        for (int row2 = rfirst; row2 < rend; row2 += 2 * rstep) {
#pragma unroll
            for (int pb = 0; pb < 2; ++pb) { const int row = row2 + pb * rstep; if (row < rend) {
                f32x4 x[4];
#pragma unroll
                for (int j = 0; j < 4; ++j) x[j] = xn[pb][j];
                asm volatile("" ::: "memory");
                { const int nrow = row + 2 * rstep; if (nrow < rend) P0B_LOAD(pb, nrow); }
                asm volatile("" ::: "memory");
                v2u* o = (v2u*)((bf16*)(F.ws + WS_HB) + (size_t)row * D) + F.lane; v2u* xo = (v2u*)((unsigned short*)(F.ws + WS_X) + (size_t)row * D) + F.lane;
#pragma unroll
                for (int j = 0; j < 4; ++j) { const f32x4 h = x[j] * psc[j] + psh[j];
                    { v2u w; w.x = pkh2(x[j].x, x[j].y); w.y = pkh2(x[j].z, x[j].w); xo[64 * j] = w; }
                    v2u w; w.x = pk2(h.x, h.y); w.y = pk2(h.z, h.w); o[64 * j] = w; }
            } }
        }
    }
#undef P0B_LOAD
}
__device__ __forceinline__ void qkpost(Frame& F, int i, bool dry = false) {
    bf16* QKV = (bf16*)(F.ws + WS_QKV);
    const float* rt = (const float*)(F.ws + WS_ROPE);
    const int j = F.lane & 7;
    float g0[8], g1[8];
#pragma unroll
    for (int e = 0; e < 8; ++e) { g0[e] = F.in[I_QKG][(size_t)(i * 2 + 0) * 64 + 8 * j + e]; g1[e] = F.in[I_QKG][(size_t)(i * 2 + 1) * 64 + 8 * j + e]; }
#define QK_COL(vec_, col_, kind_) do { if ((vec_) < 8) { col_ = (vec_) * 64; kind_ = 4; } else if ((vec_) < 16) { col_ = 512 + ((vec_) - 8) * 64; kind_ = 0; } \
        else if ((vec_) < 24) { col_ = 1536 + ((vec_) - 16) * 64; kind_ = 5; } else { col_ = 2048 + ((vec_) - 24) * 64; kind_ = 2; } } while (0)
    v4u wn[4]; v2f rn_[8];
#define QK_LOAD(r_) do { const int t_ = (r_) - NCTX; const int pos_ = (j < 4) ? (t_ >> 6) : (t_ & 63); \
        _Pragma("unroll") for (int it = 0; it < 4; ++it) { const int vec = it * 8 + (F.lane >> 3); int col, kind; QK_COL(vec, col, kind); (void)kind; \
            wn[it] = v4u{0u, 0u, 0u, 0u}; if (vec < 26) wn[it] = *(const v4u*)(QKV + (size_t)(r_) * EVEN_IN + col + 8 * j); } \
        _Pragma("unroll") for (int e = 0; e < 8; ++e) rn_[e] = v2f{1.f, 0.f}; \
        if ((r_) >= NCTX) { _Pragma("unroll") for (int e = 0; e < 8; ++e) rn_[e] = *(const v2f*)(rt + (pos_ * 16 + 8 * (j & 1) + e) * 2); } } while (0)
    if (F.gw < M) QK_LOAD(F.gw);
#pragma unroll 1
    for (int row = F.gw; row < M; row += F.NGW) {
        v4u wc[4]; float cs[8], sn[8];
#pragma unroll
        for (int it = 0; it < 4; ++it) wc[it] = wn[it];
#pragma unroll
        for (int e = 0; e < 8; ++e) { cs[e] = rn_[e].x; sn[e] = rn_[e].y; }
        asm volatile("" ::: "memory");
        { const int nrow = row + F.NGW; if (nrow < M) QK_LOAD(nrow); }
        asm volatile("" ::: "memory");
        const float sgn = (j & 2) ? 1.f : -1.f;
#pragma unroll
        for (int it = 0; it < 4; ++it) {
            const int vec = it * 8 + (F.lane >> 3); const bool act = vec < 26;
            int col; int kind; QK_COL(vec, col, kind);
            v4u* p = (v4u*)(QKV + (size_t)row * EVEN_IN + col + 8 * j);
            const v4u w = wc[it];
            float x[8] = {bf_lo(w.x), bf_hi(w.x), bf_lo(w.y), bf_hi(w.y), bf_lo(w.z), bf_hi(w.z), bf_lo(w.w), bf_hi(w.w)};
            float ss = 0.f;
#pragma unroll
            for (int e = 0; e < 8; ++e) ss += x[e] * x[e];
            ss += __shfl_xor(ss, 1); ss += __shfl_xor(ss, 2); ss += __shfl_xor(ss, 4);
            if (kind & 3) { const float rn = 1.0f / sqrtf(ss * (1.f / 64.f) + 1e-6f);
#pragma unroll
                for (int e = 0; e < 8; ++e) x[e] = x[e] * rn * ((kind & 1) ? g0[e] : g1[e]); }
            const float scl = (kind & 4) ? C2 : 1.f;
            float y[8];
#pragma unroll
            for (int e = 0; e < 8; ++e) { const float pr = __shfl_xor(x[e], 2); y[e] = (x[e] * cs[e] + sgn * pr * sn[e]) * scl; }
            if (act) { v4u o; o.x = pk2(y[0], y[1]); o.y = pk2(y[2], y[3]); o.z = pk2(y[4], y[5]); o.w = pk2(y[6], y[7]); *(dry ? (v4u*)((bf16*)(F.ws + WS_Y) + (size_t)row * EVEN_IN + col + 8 * j) : p) = o; }
        }
    }
#undef QK_LOAD
#undef QK_COL
}
__device__ __forceinline__ void ln1_phase(Frame& F, int l, bool last, bool dry = false) {
    LAS f32x4* RT = (LAS f32x4*)F.lds;
    if (F.tid < 96) ((LAS int*)(F.lds + RT_BYTES + 2048))[F.tid] = 0;
    const float* rg = F.in[I_RG] + (size_t)l * D * 4; const float* re = F.in[I_RE] + (size_t)l * D * 32;
    { f32x4 tmp[18];
#pragma unroll
      for (int it = 0; it < 18; ++it) { const int idx = F.tid + 512 * it; const int ln = idx & 63, q = (idx >> 6) % 9, ji = idx / (64 * 9); const int k = 4 * ln + 256 * (ji >> 2) + (ji & 3);
          tmp[it] = (q == 0) ? *(const f32x4*)(rg + (size_t)k * 4) : *(const f32x4*)(re + (size_t)k * 32 + 4 * (q - 1)); }
#pragma unroll
      for (int it = 0; it < 18; ++it) RT[F.tid + 512 * it] = tmp[it]; }
    __syncthreads();
    LAS float* lgs = (LAS float*)(F.lds + RT_BYTES) + F.wave * 64;
    LAS int* lcnt = (LAS int*)(F.lds + RT_BYTES + 2048);
    LAS int* recs = (LAS int*)(F.lds + RT_BYTES + 2048 + 512);
    unsigned* cnt = (unsigned*)(F.ws + WS_CTL) + CW_CNT + l * 32 * 32;
    int* elist = (int*)(F.ws + WS_ELIST); float* ewt = (float*)(F.ws + WS_EWT);
    const float* lng = F.in[I_LNG] + (size_t)(l * 2 + 0) * D; const float* lnb = F.in[I_LNB] + (size_t)(l * 2 + 0) * D;
    v2u xh[2][4], mn[2][4];
    const unsigned short* X16 = (const unsigned short*)(F.ws + WS_X);
#define LN1_LOAD(b_, r_) do { const v2u* mr_ = (const v2u*)((const bf16*)(F.ws + WS_MIX) + (size_t)(r_) * D) + F.lane; const v2u* xr_ = (const v2u*)(X16 + (size_t)(r_) * D) + F.lane; \
        _Pragma("unroll") for (int j = 0; j < 4; ++j) { xh[b_][j] = xr_[64 * j]; mn[b_][j] = mr_[64 * j]; } } while (0)
#pragma unroll 1
    for (int pass = last ? 1 : 0; pass < 2; ++pass) {
    const int s = 1 - pass;
    const int rfirst = pass ? NCTX + F.gw : (F.wave == 0 ? F.vcu : NCTX), rstep = pass ? F.NGW : F.G, rend = pass ? M : NCTX;
    if (rfirst >= rend) continue;
    f32x4 pg1[4], plg[4], plb[4], psc[4], psh[4];
    { const f32x4* g1 = (const f32x4*)modv(F, l, s, 2) + F.lane; const f32x4* sc2 = (const f32x4*)modv(F, l, s, 4) + F.lane; const f32x4* sh2 = (const f32x4*)modv(F, l, s, 3) + F.lane;
#pragma unroll
      for (int j = 0; j < 4; ++j) { pg1[j] = g1[64 * j]; plg[j] = ((const f32x4*)lng)[F.lane + 64 * j]; plb[j] = ((const f32x4*)lnb)[F.lane + 64 * j]; psc[j] = sc2[64 * j] + 1.f; psh[j] = sh2[64 * j]; } }
    LN1_LOAD(0, rfirst); if (rfirst + rstep < rend) LN1_LOAD(1, rfirst + rstep);
#pragma unroll 1
    for (int row2 = rfirst; row2 < rend; row2 += 2 * rstep) {
#pragma unroll
    for (int pb = 0; pb < 2; ++pb) { const int row = row2 + pb * rstep; if (row < rend) {
        f32x4 v[4]; float sm = 0.f, sq = 0.f;
#pragma unroll
        for (int j = 0; j < 4; ++j) { const f32x4 x = {h_lo(xh[pb][j].x), h_hi(xh[pb][j].x), h_lo(xh[pb][j].y), h_hi(xh[pb][j].y)}; const f32x4 g = pg1[j]; const v2u m = mn[pb][j];
            const f32x4 mx = {bf_lo(m.x), bf_hi(m.x), bf_lo(m.y), bf_hi(m.y)};
            v[j] = x * DN_ALPHA + g * mx; sm += (v[j].x + v[j].y) + (v[j].z + v[j].w); sq += (v[j].x * v[j].x + v[j].y * v[j].y) + (v[j].z * v[j].z + v[j].w * v[j].w); }
#pragma unroll
        for (int o = 1; o < 64; o <<= 1) { sm += __shfl_xor(sm, o); sq += __shfl_xor(sq, o); }
        const float mean = sm * (1.f / D); const float rstd = 1.0f / sqrtf(fmaxf(sq * (1.f / D) - mean * mean, 0.f) + LN_EPS);
        asm volatile("" ::: "memory");
        { const int nrow = row + 2 * rstep; if (nrow < rend) LN1_LOAD(pb, nrow); }
        asm volatile("" ::: "memory");
        v2u* xo = (v2u*)((unsigned short*)(F.ws + (dry ? WS_Y : WS_X)) + (size_t)row * D) + F.lane;
        v2u* ho = (v2u*)((bf16*)(F.ws + (dry ? WS_AO : WS_HB)) + (size_t)row * D) + F.lane;
        const LAS f32x4* RTl = RT + F.lane;
        float ag[4] = {0.f, 0.f, 0.f, 0.f};
#pragma unroll
        for (int j = 0; j < 4; ++j) {
            const f32x4 y = (v[j] - mean) * rstd * plg[j] + plb[j];
            const f32x4 h = y * psc[j] + psh[j];
            { v2u w; w.x = pkh2(y.x, y.y); w.y = pkh2(y.z, y.w); xo[64 * j] = w; } { v2u w; w.x = pk2(h.x, h.y); w.y = pk2(h.z, h.w); ho[64 * j] = w; }
            v[j] = h;
#pragma unroll
            for (int i = 0; i < 4; ++i) { const f32x4 wv = RTl[((j * 4 + i) * 9) * 64]; ag[0] += h[i] * wv.x; ag[1] += h[i] * wv.y; ag[2] += h[i] * wv.z; ag[3] += h[i] * wv.w; } }
        float lg0, lg1, lg2, lg3;
        { const bool u5 = (F.lane & 32) != 0, u4 = (F.lane & 16) != 0;
          const float t0 = (u5 ? ag[2] : ag[0]) + __shfl_xor(u5 ? ag[0] : ag[2], 32), t1 = (u5 ? ag[3] : ag[1]) + __shfl_xor(u5 ? ag[1] : ag[3], 32);
          float d = (u4 ? t1 : t0) + __shfl_xor(u4 ? t0 : t1, 16);
          d += __shfl_xor(d, 8); d += __shfl_xor(d, 4); d += __shfl_xor(d, 2); d += __shfl_xor(d, 1);
          const int di = (int)__float_as_uint(d); lg0 = __uint_as_float((unsigned)__builtin_amdgcn_readlane(di, 0)); lg1 = __uint_as_float((unsigned)__builtin_amdgcn_readlane(di, 16)); lg2 = __uint_as_float((unsigned)__builtin_amdgcn_readlane(di, 32)); lg3 = __uint_as_float((unsigned)__builtin_amdgcn_readlane(di, 48)); }
        int gs = 0; float gm = lg0; if (lg1 > gm) { gm = lg1; gs = 1; } if (lg2 > gm) { gm = lg2; gs = 2; } if (lg3 > gm) { gm = lg3; gs = 3; }
        const float ptop = 1.f / (expf(lg0 - gm) + expf(lg1 - gm) + expf(lg2 - gm) + expf(lg3 - gm));
        float ae[8] = {0.f, 0.f, 0.f, 0.f, 0.f, 0.f, 0.f, 0.f};
        { const LAS f32x4* RTg = RTl + (1 + 2 * gs) * 64;
#pragma unroll
          for (int j = 0; j < 4; ++j)
#pragma unroll
              for (int i = 0; i < 4; ++i) { const f32x4 wa = RTg[((j * 4 + i) * 9) * 64], wb = RTg[((j * 4 + i) * 9 + 1) * 64]; const float hv = v[j][i];
                  ae[0] += hv * wa.x; ae[1] += hv * wa.y; ae[2] += hv * wa.z; ae[3] += hv * wa.w; ae[4] += hv * wb.x; ae[5] += hv * wb.y; ae[6] += hv * wb.z; ae[7] += hv * wb.w; } }
        float le[8];
        { const bool u5 = (F.lane & 32) != 0, u4 = (F.lane & 16) != 0, u3 = (F.lane & 8) != 0;
          float t[4], w2[2];
#pragma unroll
          for (int i = 0; i < 4; ++i) t[i] = (u5 ? ae[4 + i] : ae[i]) + __shfl_xor(u5 ? ae[i] : ae[4 + i], 32);
#pragma unroll
          for (int i = 0; i < 2; ++i) w2[i] = (u4 ? t[2 + i] : t[i]) + __shfl_xor(u4 ? t[i] : t[2 + i], 16);
          float d = (u3 ? w2[1] : w2[0]) + __shfl_xor(u3 ? w2[0] : w2[1], 8);
          d += __shfl_xor(d, 4); d += __shfl_xor(d, 2); d += __shfl_xor(d, 1);
#pragma unroll
          for (int q = 0; q < 8; ++q) le[q] = __uint_as_float((unsigned)__builtin_amdgcn_readlane((int)__float_as_uint(d), 8 * q)); }
        { int i0 = 0; float v0 = le[0];
#pragma unroll
          for (int q = 1; q < 8; ++q) if (le[q] > v0) { v0 = le[q]; i0 = q; }
          int i1 = -1; float v1 = -INFINITY;
#pragma unroll
          for (int q = 0; q < 8; ++q) if (q != i0 && le[q] > v1) { v1 = le[q]; i1 = q; }
          const float w0 = ptop / (1.f + expf(v1 - v0)), w1 = ptop - w0;
          asm volatile("" ::: "memory");
          if (F.lane == 0 && !dry) { const int e0 = gs * 8 + i0, e1 = gs * 8 + i1;
              const int lp0 = __hip_atomic_fetch_add(lcnt + e0, 1, __ATOMIC_RELAXED, __HIP_MEMORY_SCOPE_WORKGROUP), lp1 = __hip_atomic_fetch_add(lcnt + e1, 1, __ATOMIC_RELAXED, __HIP_MEMORY_SCOPE_WORKGROUP);
              const int n = __hip_atomic_fetch_add(lcnt + 64, 2, __ATOMIC_RELAXED, __HIP_MEMORY_SCOPE_WORKGROUP);
              if (n + 2 <= LN1_MAXREC) { LAS int* r0 = recs + n * 4; r0[0] = row * 2; r0[1] = e0; r0[2] = lp0; ((LAS float*)r0)[3] = w0; r0[4] = row * 2 + 1; r0[5] = e1; r0[6] = lp1; ((LAS float*)r0)[7] = w1; } } }
        asm volatile("" ::: "memory");
    } }
    }
    }
#undef LN1_LOAD
    if (!dry) {
        __syncthreads();
        if (F.tid < NE) { const int c = lcnt[F.tid]; lcnt[32 + F.tid] = c > 0 ? (int)__hip_atomic_fetch_add(cnt + F.tid * 32, (unsigned)c, RLX_AGENT) : 0; }
        __syncthreads();
        int nrec = lcnt[64]; nrec = nrec > LN1_MAXREC ? LN1_MAXREC : nrec;
        for (int n = F.tid; n < nrec; n += 512) { const LAS int* r = recs + n * 4; const int e = r[1]; const size_t idx = (size_t)e * pg8::MOE_CAP + lcnt[32 + e] + r[2];
            elist[idx] = r[0]; ewt[idx] = ((const LAS float*)r)[3]; }
    }
}
__device__ __forceinline__ void moe_tables(Frame& F, int l) {
    LAS int* offs = (LAS int*)(F.lds + MOE_TAB_OFF); LAS int* cnts = offs + 64; LAS int* tile_exp = offs + 128; LAS int* ntl = offs + 320;
    unsigned* cnt = (unsigned*)(F.ws + WS_CTL) + CW_CNT + l * 32 * 32;
    if (F.tid < NE) cnts[F.tid] = (int)__hip_atomic_load(cnt + F.tid * 32, RLX_AGENT);
    __syncthreads();
    if (F.tid == 0) { int o = 0; for (int e = 0; e < NE; ++e) { offs[e] = o; o += (cnts[e] + 255) & ~255; } offs[32] = o; ntl[0] = o >> 8; }
    __syncthreads();
    for (int t = F.tid; t < (offs[32] >> 8); t += 512) { int e = 0; while (offs[e + 1] <= t * 256) ++e; tile_exp[t] = e; }
    __syncthreads();
}
__device__ __forceinline__ void ln2_phase(Frame& F, int l, bool last, float* out, bool dry = false) {
    const float* lng = F.in[I_LNG] + (size_t)(l * 2 + 1) * D; const float* lnb = F.in[I_LNB] + (size_t)(l * 2 + 1) * D;
    const bf16* Y = (const bf16*)(F.ws + WS_Y);
    v2u xn[2][4], an[2][4], bn[2][4];
#define LN2_LOAD(b_, r_) do { const v2u* xr_ = (const v2u*)((const unsigned short*)(F.ws + WS_X) + (size_t)(r_) * D) + F.lane; \
        const v2u* y0_ = (const v2u*)(Y + (size_t)(r_) * D) + F.lane; const v2u* y1_ = (const v2u*)(Y + ((size_t)M + (r_)) * D) + F.lane; \
        _Pragma("unroll") for (int j = 0; j < 4; ++j) { xn[b_][j] = xr_[64 * j]; an[b_][j] = y0_[64 * j]; bn[b_][j] = y1_[64 * j]; } } while (0)
#pragma unroll 1
    for (int pass = last ? 1 : 0; pass < 2; ++pass) {
        const int s = 1 - pass;
        const int rfirst = pass ? NCTX + F.gw : (F.wave == 0 ? F.vcu : NCTX), rstep = pass ? F.NGW : F.G, rend = pass ? M : NCTX;
        if (rfirst >= rend) continue;
        f32x4 pg[4], plg[4], plb[4], psc[4], psh[4];
        { const f32x4* g2 = (const f32x4*)modv(F, l, s, 5) + F.lane; const int ln_ = last ? l : l + 1;
          const f32x4* sc1 = (const f32x4*)modv(F, ln_, s, 1) + F.lane; const f32x4* sh1 = (const f32x4*)modv(F, ln_, s, 0) + F.lane;
#pragma unroll
          for (int j = 0; j < 4; ++j) { pg[j] = g2[64 * j]; plg[j] = ((const f32x4*)lng)[F.lane + 64 * j]; plb[j] = ((const f32x4*)lnb)[F.lane + 64 * j]; psc[j] = sc1[64 * j] + 1.f; psh[j] = sh1[64 * j]; } }
        LN2_LOAD(0, rfirst); if (rfirst + rstep < rend) LN2_LOAD(1, rfirst + rstep);
#pragma unroll 1
        for (int row2 = rfirst; row2 < rend; row2 += 2 * rstep) {
#pragma unroll
          for (int pb = 0; pb < 2; ++pb) { const int row = row2 + pb * rstep; if (row < rend) {
            f32x4 v[4]; float sm = 0.f;
#pragma unroll
            for (int j = 0; j < 4; ++j) { const f32x4 x = {h_lo(xn[pb][j].x), h_hi(xn[pb][j].x), h_lo(xn[pb][j].y), h_hi(xn[pb][j].y)}; const v2u a = an[pb][j], b = bn[pb][j];
                const f32x4 yy = {bf_lo(a.x) + bf_lo(b.x), bf_hi(a.x) + bf_hi(b.x), bf_lo(a.y) + bf_lo(b.y), bf_hi(a.y) + bf_hi(b.y)};
                v[j] = x * DN_ALPHA + pg[j] * yy; sm += (v[j].x + v[j].y) + (v[j].z + v[j].w); }
            asm volatile("" ::: "memory");
            { const int nrow = row + 2 * rstep; if (nrow < rend) LN2_LOAD(pb, nrow); }
            asm volatile("" ::: "memory");
            const float mean = wave_sum(sm) * (1.f / D); float s2 = 0.f;
#pragma unroll
            for (int j = 0; j < 4; ++j) { v[j] = v[j] - mean; s2 += (v[j].x * v[j].x + v[j].y * v[j].y) + (v[j].z * v[j].z + v[j].w * v[j].w); }
            const float rstd = 1.0f / sqrtf(wave_sum(s2) * (1.f / D) + LN_EPS);
            if (last) {
                f32x4* xo = (f32x4*)((dry ? (float*)(F.ws + WS_QKV) : out) + (size_t)(row - NCTX) * D) + F.lane;
#pragma unroll
                for (int j = 0; j < 4; ++j) xo[64 * j] = v[j] * rstd * plg[j] + plb[j];
            } else {
                v2u* xo = (v2u*)((unsigned short*)(F.ws + (dry ? WS_QKV : WS_X)) + (size_t)row * D) + F.lane;
                v2u* ho = (v2u*)((bf16*)(F.ws + (dry ? WS_AO : WS_HB)) + (size_t)row * D) + F.lane;
#pragma unroll
                for (int j = 0; j < 4; ++j) { const f32x4 y = v[j] * rstd * plg[j] + plb[j];
                    { v2u w; w.x = pkh2(y.x, y.y); w.y = pkh2(y.z, y.w); xo[64 * j] = w; } const f32x4 h = y * psc[j] + psh[j];
                    v2u w; w.x = pk2(h.x, h.y); w.y = pk2(h.z, h.w); ho[64 * j] = w; }
            }
          } }
        }
    }
#undef LN2_LOAD
}
__device__ __forceinline__ void attn_even_phase(Frame& F, int l, int i) {
    const att::bf16* QKV = (const att::bf16*)(F.ws + WS_QKV); att::bf16* AO = (att::bf16*)(F.ws + WS_AO);
    const int wid = F.wave;
    const float lam_init = 0.8f - 0.6f * expf(-0.3f * (float)l);
    float lam;
    { const float* dl = F.in[I_DLAM] + (size_t)i * 4 * 64; const float a = wave_sum(dl[F.lane] * dl[64 + F.lane]), b = wave_sum(dl[128 + F.lane] * dl[192 + F.lane]); lam = expf(a) - expf(b) + lam_init; }
    const float* subg = F.in[I_SUBG] + (size_t)i * 128;
    const int v = F.vcu, G = F.G;
    const int chunk = (512 + G - 1) / G;
    { int tidL = F.tid; asm volatile("" : "+v"(tidL));
      for (int k = 0; k <= chunk; ++k) {
          int head, row0, NT;
          if (k < chunk) { const int u = v * chunk + k; if (u >= 512) continue; head = u >> 7; row0 = NCTX + 128 * (u & 127); NT = M / 64; }
          else { if (v >= 8) continue; head = v >> 1; row0 = 128 * (v & 1); NT = NCTX / 64; }
          att::UnitArgs a{}; const int map = wid >> 2, rw = row0 + 32 * (wid & 3);
          a.Qw = QKV + (size_t)rw * EVEN_IN + head * 128 + map * 64; a.ldq = EVEN_IN;
          a.Kh = QKV + 512 + head * 128; a.Vh = QKV + 1024 + head * 128; a.ldk = EVEN_IN; a.NT = NT; a.kcol = map * 64;
          a.Ow = AO + (size_t)rw * D + head * 128; a.ldo = D; a.lam = lam; a.subg = subg; a.oscale = 1.f - lam_init;
          att::attn_unit<128, 128, 1>(a, (char*)F.ldsg, tidL);
      } }
    { int tidL = F.tid; asm volatile("" : "+v"(tidL));
      for (int k = 0; k <= chunk; ++k) {
          int head, row0, NT;
          if (k < chunk) { const int u = v * chunk + k; if (u >= 512) continue; head = u >> 6; row0 = NCTX + 256 * (u & 63); NT = M / 64; }
          else { if (v < 8 || v >= 16) continue; head = v - 8; row0 = 0; NT = NCTX / 64; }
          const int rw = row0 + 32 * wid;
          att::UnitArgs a{};
          a.Qw = QKV + (size_t)rw * EVEN_IN + 1536 + head * 64; a.ldq = EVEN_IN;
          a.Kh = QKV + 2048 + (head >> 2) * 64; a.Vh = QKV + 2176 + (head >> 2) * 64; a.ldk = EVEN_IN; a.NT = NT; a.kcol = 0;
          a.Ow = AO + (size_t)rw * D + 512 + head * 64; a.ldo = D;
          att::attn_unit<64, 64, 0>(a, (char*)F.ldsg, tidL);
      } }
}
__device__ __forceinline__ void attn_odd_phase(Frame& F, int l, int i, bool with_ctx) {
    const att::bf16* QKV = (const att::bf16*)(F.ws + WS_QKV); att::bf16* AO = (att::bf16*)(F.ws + WS_AO);
    const int wid = F.wave, v = F.vcu, G = F.G;
    const int chunk = (1024 + G - 1) / G;
    int tidL = threadIdx.x; asm volatile("" : "+v"(tidL));
    for (int u = v * chunk; u < (v + 1) * chunk && u < 1024; ++u) {
        const int head = u >> 6, r0 = 4 * (u & 63);
        att::UnitArgs a{};
        a.na_rq = r0 + (wid >> 1); a.na_c0 = 32 * (wid & 1);
        int kr0 = r0 - 4; kr0 = kr0 < 0 ? 0 : (kr0 > 244 ? 244 : kr0); a.na_kr0 = kr0;
        const int rw = NCTX + a.na_rq * 64 + a.na_c0;
        a.Qw = QKV + (size_t)rw * ODD_IN + head * 64; a.ldq = ODD_IN;
        a.Kh = QKV + 1024 + head * 64; a.Vh = QKV + 2048 + head * 64; a.ldk = ODD_IN; a.NT = 16; a.kcol = 0;
        a.Ow = AO + (size_t)rw * D + head * 64; a.ldo = D;
        a.rpb = F.in[I_RPB] + ((size_t)i * 16 + head) * 15 * 31;
        att::attn_unit<64, 64, 2>(a, (char*)F.ldsg, tidL);
    }
    if (with_ctx && v < 16) { const int head = v, rw = 32 * wid;
        att::UnitArgs a{};
        a.Qw = QKV + (size_t)rw * ODD_IN + head * 64; a.ldq = ODD_IN;
        a.Kh = QKV + 1024 + head * 64; a.Vh = QKV + 2048 + head * 64; a.ldk = ODD_IN; a.NT = NCTX / 64; a.kcol = 0;
        a.Ow = AO + (size_t)rw * D + head * 64; a.ldo = D;
        int tidM = threadIdx.x; asm volatile("" : "+v"(tidM));
        att::attn_unit<64, 64, 0>(a, (char*)F.ldsg, tidM); }
}

constexpr int PH_PER_LAYER = 9, N_PHASES = 2 + DEPTH * PH_PER_LAYER;
__global__ void __launch_bounds__(NWAVES * 64, 2) fwd_kernel(Args args) {
    extern __shared__ __attribute__((aligned(16))) unsigned char lds[];
    Frame F;
#define PHASE_FRAME() do { int t_ = threadIdx.x; asm volatile("" : "+v"(t_)); const int z_ = launder_i(0); const int bx_ = (int)blockIdx.x + z_; \
    F.lds = (LAS unsigned char*)lds; F.ldsg = lds; F.ws = args.ws + z_; F.in = args.in + z_; F.bx = bx_; \
    F.tid = t_; F.lane = t_ & 63; F.wave = __builtin_amdgcn_readfirstlane(t_ >> 6); \
    F.G = gridDim.x; F.vcu = (F.G % 8 == 0) ? (bx_ % 8) * (F.G / 8) + bx_ / 8 : bx_; \
    F.gw = F.vcu * NWAVES + F.wave; F.NGW = F.G * NWAVES; } while (0)
    PHASE_FRAME();
    volatile LAS unsigned* MISC = (volatile LAS unsigned*)(F.lds + MISC_OFF);
    if (F.tid < 64) MISC[F.tid] = 0u;
    __syncthreads();
    unsigned* ctl = (unsigned*)(args.ws + WS_CTL);
    XcdBarrier bar; bar.bar = ctl + CW_BAR; bar.x = 0; bar.st = nullptr;
    const int lo = args.ph_lo, hi = args.ph_hi;
    if (hi - lo > 1) bar = xcd_barrier_post(ctl + CW_BAR, MISC + 8);
#ifndef DBG_MASK
#define DBG_MASK 0xffff
#endif
#ifndef DBG_REP
#define DBG_REP 0
#endif
#define NREP(bit) ((DBG_REP & (bit)) ? 2 : 1)
#define IN(k) (lo <= (k) && (k) < hi)
#define SEAM(k) do { if (IN(k) && IN((k) + 1)) xcd_barrier(bar); } while (0)
    if ((DBG_MASK & 1) && IN(0)) for (int rep_ = 0; rep_ < NREP(1); ++rep_) { PHASE_FRAME(); p0a(F); __syncthreads(); }
    SEAM(0);
    if ((DBG_MASK & 2) && IN(1)) { PHASE_FRAME(); p0b(F); }
    SEAM(1);
    for (int lp = 0; lp < 2; ++lp) {
        { const int l = 2 * lp, i = lp, pb = 2 + l * PH_PER_LAYER;
          if ((DBG_MASK & 4) && IN(pb + 0)) for (int rep_ = 0; rep_ < NREP(4); ++rep_) { PHASE_FRAME(); pg8::Gemm g{(const bf16*)(F.ws + WS_HB), (const bf16*)(F.ws + WS_WINE) + (size_t)i * EVEN_IN * D, M, EVEN_IN, D};
              pg8::StaticOrder S0; S0.init(M, EVEN_IN, F.G, F.bx); pg8::PreOrder S; S.init(S0); pg8::EpiBf16S E{(bf16*)(F.ws + WS_QKV), EVEN_IN, 0, 1.f};
              pg8::gemm_phase<pg8::EpiBf16S, pg8::PreOrder, 1024, true, false>(F.lds, g, S, E, F.tid); }
          SEAM(pb + 0);
          if ((DBG_MASK & 8) && IN(pb + 1)) { PHASE_FRAME(); if (DBG_REP & 8) qkpost(F, i, true); qkpost(F, i); }
          SEAM(pb + 1);
          if ((DBG_MASK & 16) && IN(pb + 2)) for (int rep_ = 0; rep_ < NREP(16); ++rep_) { PHASE_FRAME(); attn_even_phase(F, l, i); }
          SEAM(pb + 2);
          if ((DBG_MASK & 4) && IN(pb + 3)) for (int rep_ = 0; rep_ < NREP(2048); ++rep_) { PHASE_FRAME(); pg8::Gemm g{(const bf16*)(F.ws + WS_AO), (const bf16*)(F.ws + WS_WOUTE) + (size_t)i * D * D, M, D, D};
              pg8::StaticOrder S0; S0.init(M, D, F.G, F.bx); pg8::PreOrder S; S.init(S0); pg8::EpiBf16S E{(bf16*)(F.ws + WS_MIX), D, 0, 1.f};
              pg8::gemm_phase<pg8::EpiBf16S, pg8::PreOrder, 1024, true, false>(F.lds, g, S, E, F.tid); }
          SEAM(pb + 3);
          if ((DBG_MASK & 64) && IN(pb + 4)) { PHASE_FRAME(); if (DBG_REP & 64) { ln1_phase(F, l, false, true); __syncthreads(); } ln1_phase(F, l, false); __syncthreads(); }
          SEAM(pb + 4);
          if ((DBG_MASK & 256) && IN(pb + 6)) for (int rep_ = 0; rep_ < NREP(256); ++rep_) { PHASE_FRAME(); moe_tables(F, l); const LAS int* mt_ = (const LAS int*)(F.lds + MOE_TAB_OFF);
              pg8::Gemm g{(const bf16*)(F.ws + WS_HB), (const bf16*)(F.ws + WS_W13) + (size_t)l * NE * 1024 * D, AS_ROWS, 1024, D};
              pg8::MoeOrder S{mt_, mt_ + 64, mt_ + 128, mt_[320], F.G, F.bx, (const int*)(F.ws + WS_ELIST), D}; pg8::EpiSwiglu E{(bf16*)(F.ws + WS_HMID)};
              pg8::gemm_phase<pg8::EpiSwiglu, pg8::MoeOrder, 1024, true, true>(F.lds, g, S, E, F.tid); }
          SEAM(pb + 6);
          if ((DBG_MASK & 512) && IN(pb + 7)) for (int rep_ = 0; rep_ < NREP(512); ++rep_) { PHASE_FRAME(); if (!IN(pb + 6)) moe_tables(F, l);     const LAS int* mt_ = (const LAS int*)(F.lds + MOE_TAB_OFF);
              pg8::Gemm g{(const bf16*)(F.ws + WS_HMID), (const bf16*)(F.ws + WS_W2) + (size_t)l * NE * D * DE, AS_ROWS, D, DE};
              pg8::MoeOrder S{mt_, mt_ + 64, mt_ + 128, mt_[320], F.G, F.bx, (const int*)(F.ws + WS_ELIST), DE};
              pg8::EpiMoeOut E{mt_, mt_ + 64, (const int*)(F.ws + WS_ELIST), (const float*)(F.ws + WS_EWT), (bf16*)(F.ws + WS_Y)};
              pg8::gemm_phase<pg8::EpiMoeOut, pg8::MoeOrder, 512, true, false>(F.lds, g, S, E, F.tid); }
          SEAM(pb + 7);
          if ((DBG_MASK & 1024) && IN(pb + 8)) { PHASE_FRAME(); if (DBG_REP & 1024) ln2_phase(F, l, false, args.out, true); ln2_phase(F, l, false, args.out); }
          SEAM(pb + 8);
        }
        { const int l = 2 * lp + 1, i = lp, pb = 2 + l * PH_PER_LAYER; const bool last = (l == DEPTH - 1);
          if ((DBG_MASK & 4) && IN(pb + 0)) for (int rep_ = 0; rep_ < NREP(4); ++rep_) { PHASE_FRAME(); pg8::Gemm g{(const bf16*)(F.ws + WS_HB), (const bf16*)(F.ws + WS_WINO) + (size_t)i * ODD_IN * D, M, ODD_IN, D};
              pg8::StaticOrder S0; S0.init(M, ODD_IN, F.G, F.bx); pg8::PreOrder S; S.init(S0); pg8::EpiBf16S E{(bf16*)(F.ws + WS_QKV), ODD_IN, 1024, C2};
              pg8::gemm_phase<pg8::EpiBf16S, pg8::PreOrder, 1024, true, false>(F.lds, g, S, E, F.tid); }
          SEAM(pb + 0);
          if ((DBG_MASK & 32) && IN(pb + 2)) for (int rep_ = 0; rep_ < NREP(32); ++rep_) { PHASE_FRAME(); attn_odd_phase(F, l, i, !last); }
          SEAM(pb + 2);
          if ((DBG_MASK & 4) && IN(pb + 3)) for (int rep_ = 0; rep_ < NREP(2048); ++rep_) { PHASE_FRAME(); const int r0_ = last ? NCTX : 0;
              pg8::Gemm g{(const bf16*)(F.ws + WS_AO) + (size_t)r0_ * D, (const bf16*)(F.ws + WS_WOUTO) + (size_t)i * D * D, M - r0_, D, D};
              pg8::StaticOrder S0; S0.init(M - r0_, D, F.G, F.bx); pg8::PreOrder S; S.init(S0); pg8::EpiBf16S E{(bf16*)(F.ws + WS_MIX) + (size_t)r0_ * D, D, 0, 1.f};
              pg8::gemm_phase<pg8::EpiBf16S, pg8::PreOrder, 1024, true, false>(F.lds, g, S, E, F.tid); }
          SEAM(pb + 3);
          if ((DBG_MASK & 64) && IN(pb + 4)) { PHASE_FRAME(); if (DBG_REP & 64) { ln1_phase(F, l, last, true); __syncthreads(); } ln1_phase(F, l, last); __syncthreads(); }
          SEAM(pb + 4);
          if ((DBG_MASK & 256) && IN(pb + 6)) for (int rep_ = 0; rep_ < NREP(256); ++rep_) { PHASE_FRAME(); moe_tables(F, l); const LAS int* mt_ = (const LAS int*)(F.lds + MOE_TAB_OFF);
              pg8::Gemm g{(const bf16*)(F.ws + WS_HB), (const bf16*)(F.ws + WS_W13) + (size_t)l * NE * 1024 * D, AS_ROWS, 1024, D};
              pg8::MoeOrder S{mt_, mt_ + 64, mt_ + 128, mt_[320], F.G, F.bx, (const int*)(F.ws + WS_ELIST), D}; pg8::EpiSwiglu E{(bf16*)(F.ws + WS_HMID)};
              pg8::gemm_phase<pg8::EpiSwiglu, pg8::MoeOrder, 1024, true, true>(F.lds, g, S, E, F.tid); }
          SEAM(pb + 6);
          if ((DBG_MASK & 512) && IN(pb + 7)) for (int rep_ = 0; rep_ < NREP(512); ++rep_) { PHASE_FRAME(); if (!IN(pb + 6)) moe_tables(F, l);     const LAS int* mt_ = (const LAS int*)(F.lds + MOE_TAB_OFF);
              pg8::Gemm g{(const bf16*)(F.ws + WS_HMID), (const bf16*)(F.ws + WS_W2) + (size_t)l * NE * D * DE, AS_ROWS, D, DE};
              pg8::MoeOrder S{mt_, mt_ + 64, mt_ + 128, mt_[320], F.G, F.bx, (const int*)(F.ws + WS_ELIST), DE};
              pg8::EpiMoeOut E{mt_, mt_ + 64, (const int*)(F.ws + WS_ELIST), (const float*)(F.ws + WS_EWT), (bf16*)(F.ws + WS_Y)};
              pg8::gemm_phase<pg8::EpiMoeOut, pg8::MoeOrder, 512, true, false>(F.lds, g, S, E, F.tid); }
          SEAM(pb + 7);
          if ((DBG_MASK & 1024) && IN(pb + 8)) { PHASE_FRAME(); if (DBG_REP & 1024) ln2_phase(F, l, last, args.out, true); ln2_phase(F, l, last, args.out); }
          SEAM(pb + 8);
        }
    }
#undef IN
#undef SEAM
}

extern "C" void kernel_launch(void* const* d_in, const int* in_sizes, int n_in, void* d_out, int out_size, void* d_ws, size_t ws_size, hipStream_t stream) {
    static int grid = 0;
    if (grid == 0) {
        if (n_in != 21 || out_size != SEQ * D || ws_size < WS_END) { fprintf(stderr, "kernel_launch: unexpected shapes (n_in %d out %d ws %zu)\n", n_in, out_size, ws_size); grid = -1; return; }
        int dev = 0, cus = 0, per_cu = 0;
        if (hipGetDevice(&dev) != hipSuccess || hipDeviceGetAttribute(&cus, hipDeviceAttributeMultiprocessorCount, dev) != hipSuccess) { grid = -1; return; }
        if (hipFuncSetAttribute((const void*)fwd_kernel, hipFuncAttributeMaxDynamicSharedMemorySize, LDS_BYTES) != hipSuccess) { fprintf(stderr, "kernel_launch: hipFuncSetAttribute failed\n"); grid = -1; return; }
        if (hipOccupancyMaxActiveBlocksPerMultiprocessor(&per_cu, (const void*)fwd_kernel, NWAVES * 64, LDS_BYTES) != hipSuccess || per_cu < 1)
            fprintf(stderr, "kernel_launch: occupancy query reports %d blocks per CU\n", per_cu);
        (void)hipGetLastError();
        grid = cus;
    }
    if (grid < 0) return;
    (void)hipMemsetAsync((char*)d_ws + WS_CTL, 0, CTL_ZERO_BYTES, stream);
    Args a{};
    for (int i = 0; i < 21; ++i) a.in[i] = (const float*)d_in[i];
    a.out = (float*)d_out; a.ws = (unsigned char*)d_ws;
#if MK_ONE_LAUNCH
    a.ph_lo = 0; a.ph_hi = N_PHASES;
    hipLaunchKernelGGL(fwd_kernel, dim3(grid), dim3(NWAVES * 64), LDS_BYTES, stream, a);
#else
#ifndef DBG_MAXPH
#define DBG_MAXPH N_PHASES
#endif
    for (int p = 0; p < DBG_MAXPH; ++p) {
        if (p >= 2 && ((p - 2) / PH_PER_LAYER) % 2 == 1 && (p - 2) % PH_PER_LAYER == 1) continue;
        a.ph_lo = p; a.ph_hi = p + 1;
        hipLaunchKernelGGL(fwd_kernel, dim3(grid), dim3(NWAVES * 64), LDS_BYTES, stream, a);
    }
#endif
    const hipError_t le = hipPeekAtLastError();
    if (le != hipSuccess) fprintf(stderr, "kernel_launch: launch failed: %s\n", hipGetErrorName(le));
}
```
